# Optimizing an MI355X kernel written in HIP

```python
import jax, jax.numpy as jnp
from jax import lax
import numpy as np

D_MODEL = 1024
BATCH = 2
SEQ = 16384
DEPTH = 1
DEC_BATCH = 32
DEC_SEQ = 2048
PAST_LEN = 128

HEAD_DIM = 64
MIX_WIDTH = D_MODEL
N_HEADS_A = (MIX_WIDTH // 2) // HEAD_DIM
N_HEADS_B = (MIX_WIDTH // 2) // HEAD_DIM
N_KV_B = N_HEADS_B // 4
DILATED_PATTERNS = ((128, 1), (512, 4), (2048, 16))
SWA_HALF_WINDOW = 128
SWA_BLOCK = 128
ROPE_THETA = 10000.0
D_FF = -(-8 * D_MODEL // (3 * 256)) * 256
EPS = 1e-6

QA = N_HEADS_A * HEAD_DIM
KA = N_HEADS_A * HEAD_DIM
VA = N_HEADS_A * HEAD_DIM
QB = N_HEADS_B * HEAD_DIM
KB = N_KV_B * HEAD_DIM
VB = N_KV_B * HEAD_DIM
IN_COLS = QA + KA + VA + QB + KB + VB

kernel_name = "hymba_dilated_swa_sink_encoder"


def rmsnorm(x, g):
    x32 = x.astype(jnp.float32)
    y = x32 * lax.rsqrt(jnp.mean(x32 * x32, axis=-1, keepdims=True) + EPS)
    return (y * g.astype(jnp.float32)).astype(x.dtype)


def rope(t, positions):
    half = HEAD_DIM // 2
    inv = ROPE_THETA ** (-2.0 * jnp.arange(half, dtype=jnp.float32) / HEAD_DIM)
    ang = positions.astype(jnp.float32)[:, None] * inv[None, :]
    cos = jnp.cos(ang)[None, :, None, :]
    sin = jnp.sin(ang)[None, :, None, :]
    t32 = t.astype(jnp.float32)
    t1, t2 = t32[..., :half], t32[..., half:]
    return jnp.concatenate([t1 * cos - t2 * sin, t2 * cos + t1 * sin], axis=-1).astype(t.dtype)


def banded_attention(q, k, v, half_window, block, sink=None):
    B, L, Hk, G, Dh = q.shape
    nb = -(-L // block)
    Lp = nb * block
    pad = Lp - L
    q32 = jnp.pad(q.astype(jnp.float32), ((0, 0), (0, pad), (0, 0), (0, 0), (0, 0)))
    kp = jnp.pad(k.astype(jnp.float32), ((0, 0), (block, pad + block), (0, 0), (0, 0)))
    vp = jnp.pad(v.astype(jnp.float32), ((0, 0), (block, pad + block), (0, 0), (0, 0)))
    qb = q32.reshape(B, nb, block, Hk, G, Dh)
    kb = kp.reshape(B, nb + 2, block, Hk, Dh)
    vb = vp.reshape(B, nb + 2, block, Hk, Dh)
    kw = jnp.concatenate([kb[:, :-2], kb[:, 1:-1], kb[:, 2:]], axis=2)
    vw = jnp.concatenate([vb[:, :-2], vb[:, 1:-1], vb[:, 2:]], axis=2)
    rel = jnp.arange(3 * block)[None, :] - block - jnp.arange(block)[:, None]
    band = jnp.abs(rel) <= half_window
    kpos = (jnp.arange(nb)[:, None] - 1) * block + jnp.arange(3 * block)[None, :]
    valid = (kpos >= 0) & (kpos < L)
    mask = band[None] & valid[:, None, :]
    scale = HEAD_DIM ** -0.5
    s = jnp.einsum('bnqhgd,bnkhd->bnhgqk', qb, kw) * scale
    s = jnp.where(mask[None, :, None, None], s, -jnp.inf)
    m = jnp.max(s, axis=-1)
    if sink is not None:
        sk = sink.astype(jnp.float32)[None, None, :, :, None]
        m = jnp.maximum(m, sk)
    p = jnp.exp(s - m[..., None])
    denom = jnp.sum(p, axis=-1)
    if sink is not None:
        denom = denom + jnp.exp(sk - m)
    o = jnp.einsum('bnhgqk,bnkhd->bnqhgd', p, vw)
    denom_t = denom.transpose(0, 1, 4, 2, 3)
    o = o / denom_t[..., None]
    lse = (m.transpose(0, 1, 4, 2, 3) + jnp.log(denom_t))
    o = o.reshape(B, Lp, Hk, G, Dh)[:, :L]
    lse = lse.reshape(B, Lp, Hk, G)[:, :L]
    return o, lse


def dilated_branch(q, k, v, window, dilation):
    B, S, H, Dh = q.shape
    L = S // dilation
    count = (window // 2) // dilation

    def to_sub(t):
        return t.reshape(B, L, dilation, H, Dh).transpose(0, 2, 1, 3, 4).reshape(B * dilation, L, H, Dh)

    o, lse = banded_attention(to_sub(q)[:, :, :, None, :], to_sub(k), to_sub(v), count, count)
    o = o.reshape(B, dilation, L, H, Dh).transpose(0, 2, 1, 3, 4).reshape(B, S, H, Dh)
    lse = lse.reshape(B, dilation, L, H).transpose(0, 2, 1, 3).reshape(B, S, H)
    return o, lse


def encoder_layer(x, attn_norm, w_in, qnorm_a, knorm_a, qnorm_b, knorm_b, sink_b,
                  w_out, ffn_norm, w_gate, w_up, w_down):
    B, S, _ = x.shape
    pos = jnp.arange(S)
    h = rmsnorm(x, attn_norm)
    proj = h @ w_in
    splits = np.cumsum([QA, KA, VA, QB, KB])
    qa, ka, va, qb, kb, vb = jnp.split(proj, splits, axis=-1)
    qa = rope(rmsnorm(qa.reshape(B, S, N_HEADS_A, HEAD_DIM), qnorm_a), pos)
    ka = rope(rmsnorm(ka.reshape(B, S, N_HEADS_A, HEAD_DIM), knorm_a), pos)
    va = va.reshape(B, S, N_HEADS_A, HEAD_DIM)
    qb = rope(rmsnorm(qb.reshape(B, S, N_HEADS_B, HEAD_DIM), qnorm_b), pos)
    kb = rope(rmsnorm(kb.reshape(B, S, N_KV_B, HEAD_DIM), knorm_b), pos)
    vb = vb.reshape(B, S, N_KV_B, HEAD_DIM)

    outs, lses = [], []
    for window, dilation in DILATED_PATTERNS:
        o, l = dilated_branch(qa, ka, va, window, dilation)
        outs.append(o)
        lses.append(l)
    wts = jax.nn.softmax(jnp.stack(lses, axis=0), axis=0)
    out_a = jnp.sum(wts[..., None] * jnp.stack(outs, axis=0), axis=0)
    out_a = out_a.reshape(B, S, QA).astype(x.dtype)

    G = N_HEADS_B // N_KV_B
    out_b, _ = banded_attention(qb.reshape(B, S, N_KV_B, G, HEAD_DIM), kb, vb,
                                SWA_HALF_WINDOW, SWA_BLOCK, sink=sink_b.reshape(N_KV_B, G))
    out_b = out_b.reshape(B, S, QB).astype(x.dtype)

    x = x + jnp.concatenate([out_a, out_b], axis=-1) @ w_out
    h2 = rmsnorm(x, ffn_norm)
    x = x + (jax.nn.silu(h2 @ w_gate) * (h2 @ w_up)) @ w_down
    return x


def setup_inputs(seed: int = 0) -> dict:
    key = jax.random.key(seed)
    ks = jax.random.split(key, 16)
    f32 = jnp.float32

    def nrm(k, shape, scale):
        return jax.random.normal(k, shape, f32) * scale

    return {
        "x_prompt": nrm(ks[0], (BATCH, SEQ, D_MODEL), 1.0),
        "x_sample": nrm(ks[1], (DEC_BATCH, DEC_SEQ, D_MODEL), 1.0),
        "attn_norm": 1.0 + nrm(ks[2], (DEPTH, D_MODEL), 0.02),
        "w_in": nrm(ks[3], (DEPTH, D_MODEL, IN_COLS), D_MODEL ** -0.5),
        "qnorm_a": 1.0 + nrm(ks[4], (DEPTH, HEAD_DIM), 0.02),
        "knorm_a": 1.0 + nrm(ks[5], (DEPTH, HEAD_DIM), 0.02),
        "qnorm_b": 1.0 + nrm(ks[6], (DEPTH, HEAD_DIM), 0.02),
        "knorm_b": 1.0 + nrm(ks[7], (DEPTH, HEAD_DIM), 0.02),
        "sink_b": nrm(ks[8], (DEPTH, N_HEADS_B), 0.5),
        "w_out": nrm(ks[9], (DEPTH, QA + QB, D_MODEL), (QA + QB) ** -0.5),
        "ffn_norm": 1.0 + nrm(ks[10], (DEPTH, D_MODEL), 0.02),
        "w_gate": nrm(ks[11], (DEPTH, D_MODEL, D_FF), D_MODEL ** -0.5),
        "w_up": nrm(ks[12], (DEPTH, D_MODEL, D_FF), D_MODEL ** -0.5),
        "w_down": nrm(ks[13], (DEPTH, D_FF, D_MODEL), D_FF ** -0.5),
    }


def reference(x_prompt, x_sample, attn_norm, w_in, qnorm_a, knorm_a, qnorm_b, knorm_b,
              sink_b, w_out, ffn_norm, w_gate, w_up, w_down):
    y_prompt = x_prompt
    y_sample = x_sample
    for i in range(DEPTH):
        params = (attn_norm[i], w_in[i], qnorm_a[i], knorm_a[i], qnorm_b[i], knorm_b[i],
                  sink_b[i], w_out[i], ffn_norm[i], w_gate[i], w_up[i], w_down[i])
        y_prompt = encoder_layer(y_prompt, *params)
        y_sample = encoder_layer(y_sample, *params)
    return (y_prompt, y_sample)
```

```cpp
#include <hip/hip_runtime.h>
#include <hip/hip_cooperative_groups.h>
#include <cstdio>
#include <cstdint>
namespace cg = cooperative_groups;
namespace pg8 {
#define PG8_LAS __attribute__((address_space(3)))
typedef unsigned short bf16_t;
typedef short bf16x8 __attribute__((ext_vector_type(8)));
typedef float f32x4 __attribute__((ext_vector_type(4)));
typedef unsigned u32x4 __attribute__((ext_vector_type(4)));
constexpr int BM = 256, BK = 64, HALF = 128, HTB = HALF * BK * 2  , STAGE_BYTES = 8 * HTB, NXCD = 8, WGM = 8;

__host__ __device__ __forceinline__ int lds_byte(int r, int c) { const int st = (r >> 4) * 2 + (c >> 5), rr = r & 15, cc = c & 31, ob = rr * 64 + cc * 2; return st * 1024 + (ob ^ (((ob >> 9) & 1) << 5)); }
__host__ __device__ __forceinline__ void stage_rc(int b, int& R, int& C) { const int st = b / 1024, sb = b % 1024, swz = sb ^ (((sb >> 9) & 1) << 5); R = (st >> 1) * 16 + swz / 64; C = (st & 1) * 32 + (swz % 64) / 2; }
__host__ __device__ __forceinline__ int perm32(int rho) { const int n = rho >> 4, i = rho & 15; return 8 * (i >> 2) + 4 * n + (i & 3); }

struct Unit { int pm, pn; };
struct Gemm { const bf16_t* A; const bf16_t* Bt; int M, N, K; };

struct StaticOrder {
    int nM, nN, nwg, G, c;
    __host__ __device__ void init(int M, int N, int G_, int c_) { nM = M / BM; nN = N / BM; nwg = nM * nN; G = G_; c = c_; }
    __host__ __device__ bool next(int i, Unit& u) const {
        const long L = (long)i * G + c; if (L >= nwg) return false;
        int wgid = (int)L; { const int q = nwg / NXCD, r = nwg % NXCD, xcd = wgid % NXCD, off = wgid / NXCD; wgid = (xcd < r ? xcd * (q + 1) : r * (q + 1) + (xcd - r) * q) + off; }
        const int nig = WGM * nN, gid = wgid / nig, fm = gid * WGM, gsz = (nM - fm) < WGM ? (nM - fm) : WGM;
        u.pm = fm + ((wgid % nig) % gsz); u.pn = (wgid % nig) / gsz; return true;
    }
    __device__ __forceinline__ void a_ready(const Unit&) const {}
    __device__ __forceinline__ void done(const Unit&) const {}
};

typedef float f32x2 __attribute__((ext_vector_type(2)));
typedef __bf16 bf16x2v __attribute__((ext_vector_type(2)));
__device__ __forceinline__ unsigned cvt_pk_bf16(float lo, float hi) { f32x2 v = {lo, hi}; bf16x2v b = __builtin_convertvector(v, bf16x2v); return __builtin_bit_cast(unsigned, b); }
template <class Epi, class Sched, bool ALIGN_EPI = false, bool SP2 = false>
__device__ __forceinline__ void gemm_phase(PG8_LAS unsigned char* lds, const Gemm g, const Sched& S, const Epi& E) {
    const int tid = threadIdx.x, wid = __builtin_amdgcn_readfirstlane(tid >> 6), lane = tid & 63, wr = wid >> 2, wc = wid & 3, fr = lane & 15, fq = lane >> 4;
    const int K = g.K, nt = K / BK;
    unsigned voffA[2], voffB[2];
#pragma unroll
    for (int i = 0; i < 2; ++i) { int R, C; stage_rc(tid * 16 + i * 8192, R, C); const int Rb = Epi::PERM ? ((R & ~31) + perm32(R & 31)) : R;
        voffA[i] = (unsigned)(R * K + C) * 2u; voffB[i] = (unsigned)(Rb * K + C) * 2u; }
    const size_t kstep = (size_t)(BK * 2);
    const size_t hstep = (size_t)HALF * K * 2;
    const size_t tstep = 2 * hstep;
    const unsigned ldsw = (unsigned)wid * 1024u;
    const int aoff = lds_byte(wr * 64 + fr, fq * 8), boff = lds_byte(wc * 32 + fr, fq * 8);
#define PG8_SA(b, h) (((b) * 2 + (h)) * HTB)
#define PG8_SB(b, h) ((4 + (b) * 2 + (h)) * HTB)
#define PG8_STAGE(bufoff, gbase, voff) do { _Pragma("unroll") for (int _i = 0; _i < 2; ++_i) \
        __builtin_amdgcn_global_load_lds((const unsigned*)((const char*)(gbase) + (voff)[_i]), (PG8_LAS unsigned*)(lds + (bufoff) + ldsw + _i * 8192), 16, 0, 0); } while (0)
#define PG8_LDA(dst, b, h) do { _Pragma("unroll") for (int m = 0; m < 4; ++m) _Pragma("unroll") for (int k = 0; k < 2; ++k) dst[m][k] = *(const PG8_LAS bf16x8*)(lds + PG8_SA(b, h) + aoff + m * 2048 + k * 1024); } while (0)
#define PG8_LDB(dst, b, h) do { _Pragma("unroll") for (int n = 0; n < 2; ++n) _Pragma("unroll") for (int k = 0; k < 2; ++k) dst[n][k] = *(const PG8_LAS bf16x8*)(lds + PG8_SB(b, h) + boff + n * 2048 + k * 1024); } while (0)
#define PG8_MMA(ai, bj, At, Bt) do { __builtin_amdgcn_s_setprio(1); _Pragma("unroll") for (int m = 0; m < 4; ++m) _Pragma("unroll") for (int n = 0; n < 2; ++n) _Pragma("unroll") for (int k = 0; k < 2; ++k) \
        acc[ai][bj][m][n] = __builtin_amdgcn_mfma_f32_16x16x32_bf16(Bt[n][k], At[m][k], acc[ai][bj][m][n], 0, 0, 0); __builtin_amdgcn_s_setprio(0); } while (0)
#define PG8_WAIT_V(n) asm volatile("s_waitcnt vmcnt(" #n ")" ::: "memory")
#define PG8_WAIT_L(n) asm volatile("s_waitcnt lgkmcnt(" #n ")" ::: "memory")
#define PG8_BAR __builtin_amdgcn_s_barrier()
#define PG8_SCHED __builtin_amdgcn_sched_barrier(0)
    Unit cur, nxt; int ui = 0;
    if (!S.next(0, cur)) return;
    f32x4 acc[2][2][4][2];
#pragma unroll
    for (int a = 0; a < 2; ++a)
#pragma unroll
        for (int b = 0; b < 2; ++b)
#pragma unroll
            for (int m = 0; m < 4; ++m)
#pragma unroll
                for (int n = 0; n < 2; ++n) acc[a][b][m][n] = (f32x4){0.f, 0.f, 0.f, 0.f};
    bf16x8 At[4][2], B0[2][2], B1[2][2];
    const char* cA = (const char*)g.A + (size_t)cur.pm * tstep; const char* cB = (const char*)g.Bt + (size_t)cur.pn * tstep;
    S.a_ready(cur);
    if constexpr (SP2) {
        PG8_STAGE(PG8_SB(0, 0), cB, voffB); PG8_STAGE(PG8_SB(0, 1), cB + hstep, voffB); PG8_STAGE(PG8_SA(0, 0), cA, voffA); PG8_STAGE(PG8_SA(0, 1), cA + hstep, voffA);
        if (wr == 1) PG8_BAR;
        PG8_WAIT_V(2); PG8_BAR;
        PG8_STAGE(PG8_SB(1, 0), cB + kstep, voffB); PG8_STAGE(PG8_SA(1, 0), cA + kstep, voffA); PG8_STAGE(PG8_SB(1, 1), cB + hstep + kstep, voffB);
        PG8_WAIT_V(6); PG8_BAR;
    } else {
        PG8_STAGE(PG8_SB(0, 0), cB, voffB); PG8_STAGE(PG8_SA(0, 0), cA, voffA); PG8_STAGE(PG8_SB(0, 1), cB + hstep, voffB); PG8_STAGE(PG8_SA(0, 1), cA + hstep, voffA);
        if (wr == 1) PG8_BAR;
        PG8_WAIT_V(4); PG8_BAR;
        PG8_STAGE(PG8_SB(1, 0), cB + kstep, voffB); PG8_STAGE(PG8_SA(1, 0), cA + kstep, voffA); PG8_STAGE(PG8_SB(1, 1), cB + hstep + kstep, voffB);
        PG8_WAIT_V(6); PG8_BAR;
    }
    for (;;) {
        const bool has_next = S.next(ui + 1, nxt);
        const char* nA = has_next ? (const char*)g.A + (size_t)nxt.pm * tstep : cA; const char* nB = has_next ? (const char*)g.Bt + (size_t)nxt.pn * tstep : cB;
        for (int t = 0; t < nt; t += 2) {
            const bool last = (t == nt - 2);
            const char* a1 = cA + (size_t)(t + 1) * kstep;
            const char* a2 = last ? nA : cA + (size_t)(t + 2) * kstep; const char* b2 = last ? nB : cB + (size_t)(t + 2) * kstep;
            const char* a3 = a2 + kstep; const char* b3 = b2 + kstep;
            if (last && has_next) S.a_ready(nxt);
            if constexpr (SP2) {
            PG8_LDB(B0, 0, 0); PG8_LDB(B1, 0, 1); PG8_SCHED; PG8_LDA(At, 0, 0); PG8_STAGE(PG8_SA(1, 1), a1 + hstep, voffA);
            PG8_WAIT_V(8); PG8_WAIT_L(0); PG8_BAR; PG8_MMA(0, 0, At, B0); PG8_MMA(0, 1, At, B1); PG8_BAR; PG8_SCHED;
            PG8_LDA(At, 0, 1); PG8_STAGE(PG8_SB(0, 0), b2, voffB); PG8_STAGE(PG8_SB(0, 1), b2 + hstep, voffB); PG8_STAGE(PG8_SA(0, 0), a2, voffA);
            PG8_WAIT_V(8); PG8_WAIT_L(0); PG8_BAR; PG8_MMA(1, 0, At, B0); PG8_MMA(1, 1, At, B1); PG8_BAR; PG8_SCHED;
            PG8_LDB(B0, 1, 0); PG8_LDB(B1, 1, 1); PG8_SCHED; PG8_LDA(At, 1, 0); PG8_STAGE(PG8_SA(0, 1), a2 + hstep, voffA);
            PG8_WAIT_V(8); PG8_WAIT_L(0); PG8_BAR; PG8_MMA(0, 0, At, B0); PG8_MMA(0, 1, At, B1); PG8_BAR; PG8_SCHED;
            PG8_LDA(At, 1, 1); PG8_STAGE(PG8_SB(1, 0), b3, voffB); PG8_STAGE(PG8_SB(1, 1), b3 + hstep, voffB); PG8_STAGE(PG8_SA(1, 0), a3, voffA);
            PG8_WAIT_V(8); PG8_WAIT_L(0); PG8_BAR; PG8_MMA(1, 0, At, B0); PG8_MMA(1, 1, At, B1); PG8_BAR; PG8_SCHED;
            } else {
            PG8_LDB(B0, 0, 0); PG8_SCHED; PG8_LDA(At, 0, 0); PG8_STAGE(PG8_SA(1, 1), a1 + hstep, voffA);
            PG8_WAIT_L(8); PG8_BAR; PG8_WAIT_L(0); PG8_MMA(0, 0, At, B0); PG8_BAR; PG8_SCHED;
            PG8_LDB(B1, 0, 1); PG8_STAGE(PG8_SB(0, 0), b2, voffB);
            PG8_BAR; PG8_WAIT_L(0); PG8_MMA(0, 1, At, B1); PG8_BAR;
            PG8_LDA(At, 0, 1); PG8_STAGE(PG8_SA(0, 0), a2, voffA);
            PG8_BAR; PG8_WAIT_L(0); PG8_MMA(1, 0, At, B0); PG8_BAR; PG8_SCHED;
            PG8_STAGE(PG8_SB(0, 1), b2 + hstep, voffB);
            PG8_WAIT_V(6); PG8_BAR; PG8_MMA(1, 1, At, B1); PG8_BAR;
            PG8_LDB(B0, 1, 0); PG8_SCHED; PG8_LDA(At, 1, 0); PG8_STAGE(PG8_SA(0, 1), a2 + hstep, voffA);
            PG8_WAIT_L(8); PG8_BAR; PG8_WAIT_L(0); PG8_MMA(0, 0, At, B0); PG8_BAR; PG8_SCHED;
            PG8_LDB(B1, 1, 1); PG8_STAGE(PG8_SB(1, 0), b3, voffB);
            PG8_BAR; PG8_WAIT_L(0); PG8_MMA(0, 1, At, B1); PG8_BAR;
            PG8_LDA(At, 1, 1); PG8_STAGE(PG8_SA(1, 0), a3, voffA);
            PG8_BAR; PG8_WAIT_L(0); PG8_MMA(1, 0, At, B0); PG8_BAR; PG8_SCHED;
            PG8_STAGE(PG8_SB(1, 1), b3 + hstep, voffB);
            PG8_WAIT_V(6); PG8_BAR; PG8_MMA(1, 1, At, B1); PG8_BAR;
            }
        }
        if constexpr (ALIGN_EPI) { if (wr == 0) PG8_BAR; }
        if constexpr (!Epi::AFTER_DRAIN) { E(acc, cur, wr, wc, fr, fq); S.done(cur); }
        if (!has_next) break;
#pragma unroll
        for (int a = 0; a < 2; ++a)
#pragma unroll
            for (int b = 0; b < 2; ++b)
#pragma unroll
                for (int m = 0; m < 4; ++m)
#pragma unroll
                    for (int n = 0; n < 2; ++n) acc[a][b][m][n] = (f32x4){0.f, 0.f, 0.f, 0.f};
        cur = nxt; cA = nA; cB = nB; ++ui;
        if constexpr (ALIGN_EPI) { if (wr == 1) PG8_BAR; }
    }
    PG8_WAIT_V(0);
    if constexpr (!ALIGN_EPI) { if (wr == 0) PG8_BAR; }
    PG8_BAR;
    if constexpr (Epi::AFTER_DRAIN) { E.fused(acc, cur, wr, wc, fr, fq, lds, wid, lane); S.done(cur); }
#undef PG8_SA
#undef PG8_SB
#undef PG8_STAGE
#undef PG8_LDA
#undef PG8_LDB
#undef PG8_MMA
#undef PG8_WAIT_V
#undef PG8_WAIT_L
#undef PG8_BAR
#undef PG8_SCHED
}
}

namespace pg8 {
constexpr int ROWS_P = 32768, SEQ_P = 16384, SEQ_S = 2048;
constexpr float QSCALE = 0.125f * 1.4426950408889634f;
constexpr float NORM_EPS = 1e-6f;
constexpr size_t HS_QKV = (size_t)(98304 + 98304 / 16) * 64;
__device__ __forceinline__ float dot4(const f32x4 a) { return (a[0] * a[0] + a[1] * a[1]) + (a[2] * a[2] + a[3] * a[3]); }

struct EpiQKV {
    static constexpr bool PERM = true, AFTER_DRAIN = false;
    bf16_t* O; const float* cosT; const float* sinT; const float* gqa; const float* gka; const float* gqb; const float* gkb;
    __device__ __forceinline__ void operator()(const f32x4 (&acc)[2][2][4][2], const Unit& u, int wr, int wc, int fr, int fq) const {
        const int pn = u.pn;
        const float* g = nullptr; float sc = 1.f;
        if (pn < 2) { g = gqa; sc = QSCALE; } else if (pn < 4) { g = gka; } else if (pn < 6) { } else if (pn < 8) { g = gqb; sc = QSCALE; } else if (wc < 2) { g = gkb; }
        f32x4 gv[2][2];
#pragma unroll
        for (int bj = 0; bj < 2; ++bj)
#pragma unroll
            for (int n = 0; n < 2; ++n) gv[bj][n] = g ? *(const f32x4*)(g + 32 * bj + 8 * fq + 4 * n) : (f32x4){1.f, 1.f, 1.f, 1.f};
        f32x4 tb[1][4];
#define QKV_LDT(k, slot) do { if (g) { const int row_ = u.pm * BM + ((k) >> 2) * HALF + wr * 64 + ((k) & 3) * 16 + fr; const int pos_ = row_ < ROWS_P ? (row_ & (SEQ_P - 1)) : (row_ & (SEQ_S - 1)); \
            tb[slot][0] = *(const f32x4*)(cosT + pos_ * 32 + 8 * fq); tb[slot][1] = *(const f32x4*)(cosT + pos_ * 32 + 8 * fq + 4); \
            tb[slot][2] = *(const f32x4*)(sinT + pos_ * 32 + 8 * fq); tb[slot][3] = *(const f32x4*)(sinT + pos_ * 32 + 8 * fq + 4); } } while (0)
        QKV_LDT(0, 0);
#pragma unroll
        for (int k = 0; k < 8; ++k) {
            const int ai = k >> 2, m = k & 3;
            const int row = u.pm * BM + ai * HALF + wr * 64 + m * 16 + fr;
            f32x4 v00 = acc[ai][0][m][0], v01 = acc[ai][0][m][1], v10 = acc[ai][1][m][0], v11 = acc[ai][1][m][1];
            if (g) {
                float ss = (dot4(v00) + dot4(v01)) + (dot4(v10) + dot4(v11));
                ss += __shfl_xor(ss, 16); ss += __shfl_xor(ss, 32);
                const float rinv = __builtin_amdgcn_rsqf(ss * (1.0f / 64.0f) + NORM_EPS);
                const f32x4 c0 = tb[0][0], c1 = tb[0][1], s0 = tb[0][2], s1 = tb[0][3];
                const f32x4 y00 = v00 * rinv * gv[0][0], y01 = v01 * rinv * gv[0][1], y10 = v10 * rinv * gv[1][0], y11 = v11 * rinv * gv[1][1];
                v00 = (y00 * c0 - y10 * s0) * sc; v10 = (y10 * c0 + y00 * s0) * sc;
                v01 = (y01 * c1 - y11 * s1) * sc; v11 = (y11 * c1 + y01 * s1) * sc;
            }
            if (k + 1 < 8) { QKV_LDT(k + 1, 0); }
            asm volatile("" ::: "memory");
            bf16_t* rowp = O + (size_t)(pn * 4 + wc) * HS_QKV + (size_t)(row + (row >> 4)) * 64 + fq * 8;
            u32x4 w0, w1;
            w0.x = cvt_pk_bf16(v00[0], v00[1]); w0.y = cvt_pk_bf16(v00[2], v00[3]); w0.z = cvt_pk_bf16(v01[0], v01[1]); w0.w = cvt_pk_bf16(v01[2], v01[3]);
            w1.x = cvt_pk_bf16(v10[0], v10[1]); w1.y = cvt_pk_bf16(v10[2], v10[3]); w1.z = cvt_pk_bf16(v11[0], v11[1]); w1.w = cvt_pk_bf16(v11[2], v11[3]);
            *(u32x4*)(rowp) = w0; *(u32x4*)(rowp + 32) = w1;
        }
#undef QKV_LDT
    }
};

struct EpiOut {
    static constexpr bool PERM = true, AFTER_DRAIN = false;
    const float* xp; const float* xs; bf16_t* xb; float* rowss;
    __device__ __forceinline__ void operator()(const f32x4 (&acc)[2][2][4][2], const Unit& u, int wr, int wc, int fr, int fq) const {
        const int row0 = u.pm * BM;
        const float* xin = row0 < ROWS_P ? xp + (size_t)row0 * 1024 : xs + (size_t)(row0 - ROWS_P) * 1024;
        const int colb = u.pn * BM + wc * 32 + fq * 8;
        f32x4 xa[2][2], xc[2][2];
#define OUT_LD(k) do { _Pragma("unroll") for (int mm_ = 0; mm_ < 2; ++mm_) { const int rl_ = ((k) >> 1) * HALF + wr * 64 + (2 * ((k) & 1) + mm_) * 16 + fr; \
            _Pragma("unroll") for (int bj_ = 0; bj_ < 2; ++bj_) { const int col_ = colb + bj_ * HALF; \
                xa[mm_][bj_] = __builtin_nontemporal_load((const f32x4*)(xin + (size_t)rl_ * 1024 + col_)); xc[mm_][bj_] = __builtin_nontemporal_load((const f32x4*)(xin + (size_t)rl_ * 1024 + col_ + 4)); } } } while (0)
        OUT_LD(0);
#pragma unroll
        for (int k = 0; k < 4; ++k) {
            const int ai = k >> 1, mh = k & 1;
            u32x4 w[2][2]; float ssv[2];
#pragma unroll
            for (int mm = 0; mm < 2; ++mm) {
                const int m = 2 * mh + mm;
                float ss = 0.f;
#pragma unroll
                for (int bj = 0; bj < 2; ++bj) {
                    const f32x4 a = xa[mm][bj] + acc[ai][bj][m][0];
                    const f32x4 b = xc[mm][bj] + acc[ai][bj][m][1];
                    ss += dot4(a) + dot4(b);
                    w[mm][bj].x = cvt_pk_bf16(a[0], a[1]); w[mm][bj].y = cvt_pk_bf16(a[2], a[3]); w[mm][bj].z = cvt_pk_bf16(b[0], b[1]); w[mm][bj].w = cvt_pk_bf16(b[2], b[3]);
                }
                ss += __shfl_xor(ss, 16); ss += __shfl_xor(ss, 32);
                ssv[mm] = ss;
            }
            if (k + 1 < 4) { OUT_LD(k + 1); }
            asm volatile("" ::: "memory");
#pragma unroll
            for (int mm = 0; mm < 2; ++mm) {
                const int m = 2 * mh + mm;
                const int rl = ai * HALF + wr * 64 + m * 16 + fr; const size_t row = (size_t)row0 + rl;
#pragma unroll
                for (int bj = 0; bj < 2; ++bj) *(u32x4*)(xb + row * 1024 + colb + bj * HALF) = w[mm][bj];
                if (fq == 0) atomicAdd(rowss + row, ssv[mm]);
            }
        }
#undef OUT_LD
    }
};

struct EpiGU {
    static constexpr bool PERM = true, AFTER_DRAIN = false;
    bf16_t* H; const float* rowss;
    __device__ __forceinline__ void operator()(const f32x4 (&acc)[2][2][4][2], const Unit& u, int wr, int wc, int fr, int fq) const {
        const int colh = u.pn * HALF + wc * 32 + fq * 8;
        float rsv[2][4];
#pragma unroll
        for (int ai = 0; ai < 2; ++ai)
#pragma unroll
            for (int m = 0; m < 4; ++m) rsv[ai][m] = rowss[(size_t)u.pm * BM + ai * HALF + wr * 64 + m * 16 + fr];
#pragma unroll
        for (int ai = 0; ai < 2; ++ai)
#pragma unroll
            for (int m = 0; m < 4; ++m) rsv[ai][m] = __builtin_amdgcn_rsqf(rsv[ai][m] * (1.0f / 1024.0f) + NORM_EPS);
#pragma unroll
        for (int ai = 0; ai < 2; ++ai)
#pragma unroll
            for (int m = 0; m < 4; ++m) {
                const size_t row = (size_t)u.pm * BM + ai * HALF + wr * 64 + m * 16 + fr;
                const float rstd = rsv[ai][m]; const float k1 = -rstd * 1.4426950408889634f, k2 = rstd * rstd;
                float hv[8];
#pragma unroll
                for (int n = 0; n < 2; ++n)
#pragma unroll
                    for (int i = 0; i < 4; ++i) {
                        const float ga = acc[ai][0][m][n][i], ua = acc[ai][1][m][n][i];
                        const float e = __builtin_amdgcn_exp2f(ga * k1);
                        hv[n * 4 + i] = (ga * ua) * (k2 * __builtin_amdgcn_rcpf(1.0f + e));
                    }
                u32x4 w; w.x = cvt_pk_bf16(hv[0], hv[1]); w.y = cvt_pk_bf16(hv[2], hv[3]); w.z = cvt_pk_bf16(hv[4], hv[5]); w.w = cvt_pk_bf16(hv[6], hv[7]);
                *(u32x4*)(H + row * 2816 + colh) = w;
            }
    }
};

struct EpiDown {
    static constexpr bool PERM = true, AFTER_DRAIN = false;
    float* out; const bf16_t* xb;
    __device__ __forceinline__ void operator()(const f32x4 (&acc)[2][2][4][2], const Unit& u, int wr, int wc, int fr, int fq) const {
        const int colb = u.pn * BM + wc * 32 + fq * 8;
        u32x4 xw[2][2];
#define DN_LD(k) do { _Pragma("unroll") for (int mm_ = 0; mm_ < 2; ++mm_) { const size_t row_ = (size_t)u.pm * BM + ((k) >> 1) * HALF + wr * 64 + (2 * ((k) & 1) + mm_) * 16 + fr; \
            _Pragma("unroll") for (int bj_ = 0; bj_ < 2; ++bj_) xw[mm_][bj_] = *(const u32x4*)(xb + row_ * 1024 + colb + bj_ * HALF); } } while (0)
        DN_LD(0);
#pragma unroll
        for (int k = 0; k < 4; ++k) {
            const int ai = k >> 1, mh = k & 1;
            f32x4 ra[2][2], rb[2][2];
#pragma unroll
            for (int mm = 0; mm < 2; ++mm) {
                const int m = 2 * mh + mm;
#pragma unroll
                for (int bj = 0; bj < 2; ++bj) {
                    const u32x4 w = xw[mm][bj];
                    f32x4 xa, xc;
                    xa[0] = __builtin_bit_cast(float, w.x << 16); xa[1] = __builtin_bit_cast(float, w.x & 0xffff0000u); xa[2] = __builtin_bit_cast(float, w.y << 16); xa[3] = __builtin_bit_cast(float, w.y & 0xffff0000u);
                    xc[0] = __builtin_bit_cast(float, w.z << 16); xc[1] = __builtin_bit_cast(float, w.z & 0xffff0000u); xc[2] = __builtin_bit_cast(float, w.w << 16); xc[3] = __builtin_bit_cast(float, w.w & 0xffff0000u);
                    ra[mm][bj] = xa + acc[ai][bj][m][0]; rb[mm][bj] = xc + acc[ai][bj][m][1];
                }
            }
            if (k + 1 < 4) { DN_LD(k + 1); }
            asm volatile("" ::: "memory");
#pragma unroll
            for (int mm = 0; mm < 2; ++mm) {
                const size_t row = (size_t)u.pm * BM + ai * HALF + wr * 64 + (2 * mh + mm) * 16 + fr;
#pragma unroll
                for (int bj = 0; bj < 2; ++bj) { float* p = out + row * 1024 + colb + bj * HALF; *(f32x4*)p = ra[mm][bj]; *(f32x4*)(p + 4) = rb[mm][bj]; }
            }
        }
#undef DN_LD
    }
};
}

#ifndef PG8_SP2
#define PG8_SP2 true
#endif
#ifndef PG8_ALIGN
#define PG8_ALIGN true
#endif

constexpr int NWAVES = 8;
constexpr int D = 1024, M = 98304, NIN = 2304, DFF = 2816, NGU = 2 * DFF;
constexpr int ROWS_P = pg8::ROWS_P, SEQ_P = pg8::SEQ_P, SEQ_S = pg8::SEQ_S;
constexpr size_t MiB = 1u << 20;
constexpr size_t WS_ROWSS = 0;
constexpr size_t WS_BAR = 512 * 1024, WS_BAR_BYTES = 16384;
constexpr size_t WS_COS = 1 * MiB, WS_SIN = 3 * MiB;
constexpr size_t WS_WIN = 8 * MiB;
constexpr size_t WS_WOUT = 13 * MiB;
constexpr size_t WS_WGU = 15 * MiB;
constexpr size_t WS_WDN = 26 * MiB;
constexpr size_t WS_XN = 32 * MiB;
constexpr size_t WS_QKV = 232 * MiB;
constexpr size_t WS_H = WS_QKV;
constexpr size_t WS_XB = 768 * MiB;
constexpr size_t WS_END = 960 * MiB;
static_assert(WS_XN + (size_t)M * D * 2 <= WS_QKV && WS_H + (size_t)M * DFF * 2 <= WS_XB && WS_XB + (size_t)M * D * 2 <= WS_END, "d_ws map");

constexpr int RING_BYTES = 131072, LDS_BYTES = 147456;

#define GAS __attribute__((address_space(1)))
#define LAS __attribute__((address_space(3)))
typedef unsigned short bf16;
typedef unsigned v4u __attribute__((ext_vector_type(4)));
typedef float f32x4 __attribute__((ext_vector_type(4)));
__device__ __forceinline__ unsigned f2bf(float f) { unsigned u = __builtin_bit_cast(unsigned, f); return (u + 0x7fffu + ((u >> 16) & 1u)) >> 16; }
__device__ __forceinline__ unsigned pk2(float lo, float hi) { return pg8::cvt_pk_bf16(lo, hi); }
__device__ __forceinline__ float wave_sum(float v) {
#pragma unroll
    for (int o = 1; o < 64; o <<= 1) v += __shfl_xor(v, o);
    return v;
}

__device__ __forceinline__ void p0_transpose_item(const float* W, int K, int N, bf16* WT, int dst_row0, const float* gain, LAS float* scr, int kb, int nb, int lane) {
    const int k0 = 64 * kb, n0 = 32 * nb;
#pragma unroll 8
    for (int i = 0; i < 32; ++i) { const int kk = 2 * i + (lane >> 5); float v = W[(size_t)(k0 + kk) * N + n0 + (lane & 31)]; if (gain) v *= gain[k0 + kk]; scr[kk * 33 + (lane & 31)] = v; }
    asm volatile("s_waitcnt lgkmcnt(0)" ::: "memory");
    const int c = lane & 7;
#pragma unroll
    for (int j = 0; j < 4; ++j) { const int n = (lane >> 3) + 8 * j; const LAS float* s = scr + (8 * c) * 33 + n;
        v4u o; o.x = pk2(s[0 * 33], s[1 * 33]); o.y = pk2(s[2 * 33], s[3 * 33]); o.z = pk2(s[4 * 33], s[5 * 33]); o.w = pk2(s[6 * 33], s[7 * 33]);
        *(v4u*)(WT + (size_t)(dst_row0 + n) * K + k0 + 8 * c) = o; }
    asm volatile("s_waitcnt lgkmcnt(0)" ::: "memory");
}

__device__ const float ROPE_INV[32] = {
    1.000000000e+00f, 7.498942614e-01f, 5.623413324e-01f, 4.216965139e-01f, 3.162277639e-01f, 2.371373773e-01f, 1.778279394e-01f, 1.333521307e-01f,
    1.000000015e-01f, 7.498941571e-02f, 5.623413250e-02f, 4.216965288e-02f, 3.162277490e-02f, 2.371373773e-02f, 1.778279431e-02f, 1.333521493e-02f,
    9.999999776e-03f, 7.498941850e-03f, 5.623413250e-03f, 4.216964822e-03f, 3.162277630e-03f, 2.371373586e-03f, 1.778279431e-03f, 1.333521446e-03f,
    1.000000047e-03f, 7.498942432e-04f, 5.623413017e-04f, 4.216965172e-04f, 3.162277571e-04f, 2.371373703e-04f, 1.778279402e-04f, 1.333521504e-04f};

__device__ __forceinline__ void rope_entry(int pos, int j, float& co, float& si) {
    const float ang = (float)pos * ROPE_INV[j];
    const double a = (double)ang;
    const double k = __builtin_rint(a * 0.15915494309189535);
    double r = __builtin_fma(-k, 6.283185307179586, a); r = __builtin_fma(-k, 2.4492935982947064e-16, r);
    const double q = __builtin_rint(r * 0.6366197723675814);
    double x = __builtin_fma(-q, 1.5707963267948966, r); x = __builtin_fma(-q, 6.123233995736766e-17, x);
    const double x2 = x * x;
    const double s = x * (1.0 + x2 * (-1.0 / 6 + x2 * (1.0 / 120 + x2 * (-1.0 / 5040 + x2 * (1.0 / 362880 + x2 * (-1.0 / 39916800 + x2 * (1.0 / 6227020800.0)))))));
    const double c = 1.0 + x2 * (-0.5 + x2 * (1.0 / 24 + x2 * (-1.0 / 720 + x2 * (1.0 / 40320 + x2 * (-1.0 / 3628800 + x2 * (1.0 / 479001600 + x2 * (-1.0 / 87178291200.0)))))));
    const int qi = ((int)q) & 3;
    const double sn = (qi == 0) ? s : (qi == 1) ? c : (qi == 2) ? -s : -c;
    const double cs = (qi == 0) ? c : (qi == 1) ? -s : (qi == 2) ? -c : s;
    co = (float)cs; si = (float)sn;
}

namespace att {
typedef short bf16x8 __attribute__((ext_vector_type(8)));
typedef short s16x4 __attribute__((ext_vector_type(4)));
typedef float f32x16 __attribute__((ext_vector_type(16)));
typedef unsigned u32x4 __attribute__((ext_vector_type(4)));
typedef unsigned u32x2 __attribute__((ext_vector_type(2)));
typedef float f32x2_t __attribute__((ext_vector_type(2))); typedef __bf16 bf16x2_t __attribute__((ext_vector_type(2)));
typedef short v4i16_t __attribute__((ext_vector_type(4)));
constexpr int QP = 64;
constexpr size_t HS = (size_t)(M + M / 16) * 64;
__device__ __forceinline__ size_t rofs(int r) { return (size_t)(r + (r >> 4)) * 64; }
constexpr int VS = 144;
constexpr int VIMG_BYTES = 32 * VS;
constexpr int LDS_O1 = NWAVES * 2 * VIMG_BYTES, O1S = 136, LDS_L1 = LDS_O1 + 512 * O1S, LDS_ATT_END = LDS_L1 + 512 * 4;
static_assert(LDS_ATT_END <= LDS_BYTES, "attention LDS map");
constexpr int N_UNITS_A = (M / 512) * 8, N_ITEMS_B = M / 32 * 8;
#ifndef ATT_REP_A
#define ATT_REP_A 1
#endif
#ifndef ATT_REP_B
#define ATT_REP_B 1
#endif
__device__ __forceinline__ unsigned cvtpk(float lo, float hi) { f32x2_t v = {lo, hi}; bf16x2_t b = __builtin_convertvector(v, bf16x2_t); return __builtin_bit_cast(unsigned, b); }
__device__ __forceinline__ s16x4 vtr(const LAS char* p) { return __builtin_bit_cast(s16x4, __builtin_amdgcn_ds_read_tr16_b64_v4i16((LAS v4i16_t*)p)); }
__device__ __forceinline__ float bflo(unsigned w) { return __builtin_bit_cast(float, w << 16); }
__device__ __forceinline__ float bfhi(unsigned w) { return __builtin_bit_cast(float, w & 0xffff0000u); }

__device__ __forceinline__ f32x16 qk(const bf16x8 (&kf)[4], const bf16x8 (&qf)[4]) {
    f32x16 sc;
#pragma unroll
    for (int r = 0; r < 16; ++r) sc[r] = 0.f;
#pragma unroll
    for (int s = 0; s < 4; ++s) sc = __builtin_amdgcn_mfma_f32_32x32x16_bf16(kf[s], qf[s], sc, 0, 0, 0);
    return sc;
}

__device__ __forceinline__ void tile_finish(f32x16& o0, f32x16& o1, float& lsum, f32x16 sc, const bf16x8 (&vf)[4], bool safe, int tb, int lb, int L) {
    if (!safe) {
#pragma unroll
        for (int r = 0; r < 16; ++r) {
            const int cr = (r & 3) + 8 * (r >> 2);
            const bool ok = ((unsigned)(tb + cr) <= 128u) && ((unsigned)(lb + cr) < (unsigned)L);
            sc[r] = ok ? sc[r] : -INFINITY;
        }
    }
    float p[16];
#pragma unroll
    for (int r = 0; r < 16; ++r) { p[r] = __builtin_amdgcn_exp2f(sc[r]); lsum += p[r]; }
    u32x4 pw0, pw1;
    pw0.x = cvtpk(p[0], p[1]); pw0.y = cvtpk(p[2], p[3]); pw0.z = cvtpk(p[4], p[5]); pw0.w = cvtpk(p[6], p[7]);
    pw1.x = cvtpk(p[8], p[9]); pw1.y = cvtpk(p[10], p[11]); pw1.z = cvtpk(p[12], p[13]); pw1.w = cvtpk(p[14], p[15]);
    const bf16x8 pf0 = __builtin_bit_cast(bf16x8, pw0), pf1 = __builtin_bit_cast(bf16x8, pw1);
    o0 = __builtin_amdgcn_mfma_f32_32x32x16_bf16(vf[0], pf0, o0, 0, 0, 0);
    o1 = __builtin_amdgcn_mfma_f32_32x32x16_bf16(vf[1], pf0, o1, 0, 0, 0);
    o0 = __builtin_amdgcn_mfma_f32_32x32x16_bf16(vf[2], pf1, o0, 0, 0, 0);
    o1 = __builtin_amdgcn_mfma_f32_32x32x16_bf16(vf[3], pf1, o1, 0, 0, 0);
}
__device__ __forceinline__ void tile_block(f32x16& o0, f32x16& o1, float& lsum, const bf16x8 (&qf)[4], const bf16x8 (&kf)[4], const bf16x8 (&vf)[4], bool safe, int tb, int lb, int L) {
    tile_finish(o0, o1, lsum, qk(kf, qf), vf, safe, tb, lb, L);
}
__device__ __forceinline__ void load_kv2(u32x4 (&kn)[4], u32x4 (&vn)[4], const bf16* kbase, const bf16* vbase, int l0, int L, int rho, int shift, int lane) {
#pragma unroll
    for (int c = 0; c < 4; ++c) { int lv = l0 + 8 * c + (lane >> 3); lv = lv < 0 ? 0 : (lv > L - 1 ? L - 1 : lv);
        const size_t ro = rofs(rho + (lv << shift));
        kn[c] = *(const u32x4*)(kbase + ro); vn[c] = *(const u32x4*)(vbase + ro); }
}
__device__ __forceinline__ void pre_kv(u32x4 (&kn)[4], u32x4 (&vn)[4], const bf16* kbase, const bf16* vbase, int lstart, int L, int rho, int shift, int lane) {
    const int b_lo = (lstart < -31) ? ((-lstart) >> 5) : 0;
    load_kv2(kn, vn, kbase, vbase, lstart + 32 * b_lo, L, rho, shift, lane);
}
template <bool DUAL>
__device__ __forceinline__ void run_branch2(f32x16& oA0, f32x16& oA1, float& lsA, const bf16x8 (&qfA)[4], f32x16& oB0, f32x16& oB1, float& lsB, const bf16x8 (&qfB)[4],
                                            const bf16* kbase, const bf16* vbase, int rho, int shift, int L, int lstart, u32x4 (&kn)[4], u32x4 (&vn)[4], LAS char* vimg, int lane) {
    const int qi = lane & 31, hi = lane >> 5;
    const int tqA = qi - 4 * hi, tqB = tqA + 32;
    const int b_lo = (lstart < -31) ? ((-lstart) >> 5) : 0;
    int b_hi = (L - lstart + 31) >> 5; if (b_hi > (DUAL ? 6 : 5)) b_hi = DUAL ? 6 : 5;
    const LAS char* krd = vimg + qi * VS + hi * 16;
    const LAS char* vrd = vimg + VIMG_BYTES + (4 * hi + ((lane & 15) >> 2)) * VS + ((lane >> 4) & 1) * 32 + (lane & 3) * 8;
    LAS char* kwr = vimg + (lane >> 3) * VS + (lane & 7) * 16;
#pragma unroll 1
    for (int b = b_lo; b < b_hi; ++b) {
#pragma unroll
        for (int c = 0; c < 4; ++c) { *(LAS u32x4*)(kwr + c * 8 * VS) = kn[c]; *(LAS u32x4*)(kwr + VIMG_BYTES + c * 8 * VS) = vn[c]; }
        if (b + 1 < b_hi) load_kv2(kn, vn, kbase, vbase, lstart + 32 * (b + 1), L, rho, shift, lane);
        bf16x8 kf[4], vf[4];
#pragma unroll
        for (int s = 0; s < 4; ++s) kf[s] = *(const LAS bf16x8*)(krd + 32 * s);
#define ATT_VF(t, d0) __builtin_shufflevector(vtr(vrd + (16 * (t)) * VS + 64 * (d0)), vtr(vrd + (16 * (t) + 8) * VS + 64 * (d0)), 0, 1, 2, 3, 4, 5, 6, 7)
        vf[0] = ATT_VF(0, 0); vf[1] = ATT_VF(0, 1); vf[2] = ATT_VF(1, 0); vf[3] = ATT_VF(1, 1);
#undef ATT_VF
        const int l0 = lstart + 32 * b;
        const bool inr = (l0 >= 0) && (l0 + 31 < L);
        if (b <= 4) tile_block(oA0, oA1, lsA, qfA, kf, vf, inr && b >= 1 && b <= 3, 32 * b - tqA, l0 + 4 * hi, L);
        if (DUAL && b >= 1) tile_block(oB0, oB1, lsB, qfB, kf, vf, inr && b >= 2 && b <= 4, 32 * b - tqB, l0 + 4 * hi, L);
    }
}

__device__ __forceinline__ void run_branch1(f32x16& o0, f32x16& o1, float& lsum, const bf16x8 (&qf)[4], const bf16* kbase, const bf16* vbase, int rho, int shift, int L, int lstart,
                                            u32x4 (&kn)[4], u32x4 (&vn)[4], LAS char* vimg, int lane) {
    const int qi = lane & 31, hi = lane >> 5;
    const int tq = qi - 4 * hi;
    const int b_lo = (lstart < -31) ? ((-lstart) >> 5) : 0;
    int b_hi = (L - lstart + 31) >> 5; if (b_hi > 5) b_hi = 5;
    const LAS char* krd = vimg + qi * VS + hi * 16;
    const LAS char* vrd = vimg + VIMG_BYTES + (4 * hi + ((lane & 15) >> 2)) * VS + ((lane >> 4) & 1) * 32 + (lane & 3) * 8;
    LAS char* kwr = vimg + (lane >> 3) * VS + (lane & 7) * 16;
#define ATT_VF(t, d0) __builtin_shufflevector(vtr(vrd + (16 * (t)) * VS + 64 * (d0)), vtr(vrd + (16 * (t) + 8) * VS + 64 * (d0)), 0, 1, 2, 3, 4, 5, 6, 7)
#define R1_STAGE_QK(bn, scX, vfX) do { \
        _Pragma("unroll") for (int c = 0; c < 4; ++c) { *(LAS u32x4*)(kwr + c * 8 * VS) = kn[c]; *(LAS u32x4*)(kwr + VIMG_BYTES + c * 8 * VS) = vn[c]; } \
        if ((bn) + 1 < b_hi) load_kv2(kn, vn, kbase, vbase, lstart + 32 * ((bn) + 1), L, rho, shift, lane); \
        bf16x8 kf_[4]; \
        _Pragma("unroll") for (int s = 0; s < 4; ++s) kf_[s] = *(const LAS bf16x8*)(krd + 32 * s); \
        scX = qk(kf_, qf); \
        vfX[0] = ATT_VF(0, 0); vfX[1] = ATT_VF(0, 1); vfX[2] = ATT_VF(1, 0); vfX[3] = ATT_VF(1, 1); } while (0)
#define R1_FIN(bb, scX, vfX) do { const int l0_ = lstart + 32 * (bb); \
        tile_finish(o0, o1, lsum, scX, vfX, (l0_ >= 0) && (l0_ + 31 < L) && (bb) >= 1 && (bb) <= 3, 32 * (bb) - tq, l0_ + 4 * hi, L); } while (0)
    f32x16 scA, scB; bf16x8 vfA[4], vfB[4];
    int b = b_lo;
    R1_STAGE_QK(b, scA, vfA);
#pragma unroll 1
    for (; b + 1 < b_hi; b += 2) {
        R1_STAGE_QK(b + 1, scB, vfB);
        R1_FIN(b, scA, vfA);
        if (b + 2 < b_hi) R1_STAGE_QK(b + 2, scA, vfA);
        R1_FIN(b + 1, scB, vfB);
    }
    if (b < b_hi) R1_FIN(b, scA, vfA);
#undef R1_STAGE_QK
#undef R1_FIN
#undef ATT_VF
}

__device__ __forceinline__ void store_out(const f32x16& o0, const f32x16& o1, float inv, bf16* out0, size_t rstride, LAS char* stg, int lane) {
    const int qi = lane & 31, hi = lane >> 5;
    LAS char* w = stg + qi * VS + 8 * hi;
#pragma unroll
    for (int c = 0; c < 4; ++c) {
        u32x2 w0, w1;
        w0.x = cvtpk(o0[4 * c] * inv, o0[4 * c + 1] * inv); w0.y = cvtpk(o0[4 * c + 2] * inv, o0[4 * c + 3] * inv);
        w1.x = cvtpk(o1[4 * c] * inv, o1[4 * c + 1] * inv); w1.y = cvtpk(o1[4 * c + 2] * inv, o1[4 * c + 3] * inv);
        *(LAS u32x2*)(w + 16 * c) = w0; *(LAS u32x2*)(w + 64 + 16 * c) = w1;
    }
#pragma unroll
    for (int j = 0; j < 4; ++j) {
        const int row = 8 * j + (lane >> 3), ch = lane & 7;
        const u32x4 v = *(const LAS u32x4*)(stg + row * VS + ch * 16);
        *(u32x4*)(out0 + (size_t)row * rstride + ch * 8) = v;
    }
}

__device__ __forceinline__ void attention_phase(const bf16* QKV, bf16* AO, const float* sink, LAS unsigned char* lds, int vcu, int G, int wave, int lane) {
    const int qi = lane & 31, hi = lane >> 5;
    LAS char* vimg = (LAS char*)lds + wave * (2 * VIMG_BYTES);
    LAS char* O1 = (LAS char*)lds + LDS_O1; LAS float* L1 = (LAS float*)((LAS char*)lds + LDS_L1);
    {
    u32x4 kn[4], vn[4]; bf16x8 qA[4], qB[4];
#define QLD(dst, hh, row) do { const bf16* qp_ = QKV + (size_t)(hh) * HS + rofs((int)(row)) + 8 * hi; _Pragma("unroll") for (int s_ = 0; s_ < 4; ++s_) dst[s_] = *(const bf16x8*)(qp_ + 16 * s_); } while (0)
#define UNIT_PARAMS(uu, h, S, seq_row, pc, kb_, vb_) const int h = (uu) / (M / 512); const int rowc_##h = ((uu) % (M / 512)) * 512; const int S = rowc_##h < ROWS_P ? SEQ_P : SEQ_S; \
        const int seq_row = rowc_##h & ~(S - 1), pc = rowc_##h - seq_row; const bf16* kb_ = QKV + rofs(seq_row) + (8 + h) * HS + (lane & 7) * 8; const bf16* vb_ = QKV + rofs(seq_row) + (16 + h) * HS + (lane & 7) * 8
    if (vcu < N_UNITS_A) { UNIT_PARAMS(vcu, h0, S0, sr0, pc0, kb0, vb0); const int P0 = pc0 + 64 * wave;
        QLD(qA, h0, sr0 + P0 + qi); QLD(qB, h0, sr0 + P0 + 32 + qi); pre_kv(kn, vn, kb0, vb0, P0 - 64, S0, 0, 0, lane); }
    for (int u = vcu; u < N_UNITS_A; u += G) {
        UNIT_PARAMS(u, h, S, seq_row, pc, kb_, vb_);
        {
            const int P0 = pc + 64 * wave;
            f32x16 oA0, oA1, oB0, oB1; float lsA = 0.f, lsB = 0.f;
#pragma unroll
            for (int r = 0; r < 16; ++r) { oA0[r] = 0.f; oA1[r] = 0.f; oB0[r] = 0.f; oB1[r] = 0.f; }
            run_branch2<true>(oA0, oA1, lsA, qA, oB0, oB1, lsB, qB, kb_, vb_, 0, 0, S, P0 - 64, kn, vn, vimg, lane);
            { const int P0b = pc + (wave & 3) + 256 * (wave >> 2);
              QLD(qA, h, seq_row + P0b + 4 * qi); QLD(qB, h, seq_row + P0b + 128 + 4 * qi); pre_kv(kn, vn, kb_, vb_, (P0b >> 2) - 64, S >> 2, P0b & 3, 2, lane); }
            lsA += __shfl_xor(lsA, 32); lsB += __shfl_xor(lsB, 32);
            LAS char* orowA = O1 + (64 * wave + qi) * O1S + 8 * hi; LAS char* orowB = orowA + 32 * O1S;
#pragma unroll
            for (int c = 0; c < 4; ++c) {
                u32x2 w0, w1;
                w0.x = cvtpk(oA0[4 * c], oA0[4 * c + 1]); w0.y = cvtpk(oA0[4 * c + 2], oA0[4 * c + 3]);
                w1.x = cvtpk(oA1[4 * c], oA1[4 * c + 1]); w1.y = cvtpk(oA1[4 * c + 2], oA1[4 * c + 3]);
                *(LAS u32x2*)(orowA + 16 * c) = w0; *(LAS u32x2*)(orowA + 64 + 16 * c) = w1;
                w0.x = cvtpk(oB0[4 * c], oB0[4 * c + 1]); w0.y = cvtpk(oB0[4 * c + 2], oB0[4 * c + 3]);
                w1.x = cvtpk(oB1[4 * c], oB1[4 * c + 1]); w1.y = cvtpk(oB1[4 * c + 2], oB1[4 * c + 3]);
                *(LAS u32x2*)(orowB + 16 * c) = w0; *(LAS u32x2*)(orowB + 64 + 16 * c) = w1;
            }
            if (hi == 0) { L1[64 * wave + qi] = lsA; L1[64 * wave + 32 + qi] = lsB; }
        }
        __syncthreads();
        {
            const int c = wave & 3, tp = wave >> 2, P0 = pc + c + 256 * tp;
            f32x16 oA0, oA1, oB0, oB1; float lsA = 0.f, lsB = 0.f;
#pragma unroll
            for (int r = 0; r < 16; ++r) { oA0[r] = 0.f; oA1[r] = 0.f; oB0[r] = 0.f; oB1[r] = 0.f; }
            run_branch2<true>(oA0, oA1, lsA, qA, oB0, oB1, lsB, qB, kb_, vb_, P0 & 3, 2, S >> 2, (P0 >> 2) - 64, kn, vn, vimg, lane);
            { const int P0c = pc + wave;
              QLD(qA, h, seq_row + P0c + 16 * qi); pre_kv(kn, vn, kb_, vb_, (P0c >> 4) - 64, S >> 4, P0c & 15, 4, lane); }
            lsA += __shfl_xor(lsA, 32); lsB += __shfl_xor(lsB, 32);
            const int lrowA = P0 - pc + 4 * qi, lrowB = lrowA + 128;
            lsA += L1[lrowA]; lsB += L1[lrowB];
            LAS char* prowA = O1 + lrowA * O1S + 8 * hi; LAS char* prowB = prowA + 128 * O1S;
#pragma unroll
            for (int cc = 0; cc < 4; ++cc) {
                u32x2 r0 = *(const LAS u32x2*)(prowA + 16 * cc), r1 = *(const LAS u32x2*)(prowA + 64 + 16 * cc);
                u32x2 w0, w1;
                w0.x = cvtpk(oA0[4 * cc] + bflo(r0.x), oA0[4 * cc + 1] + bfhi(r0.x)); w0.y = cvtpk(oA0[4 * cc + 2] + bflo(r0.y), oA0[4 * cc + 3] + bfhi(r0.y));
                w1.x = cvtpk(oA1[4 * cc] + bflo(r1.x), oA1[4 * cc + 1] + bfhi(r1.x)); w1.y = cvtpk(oA1[4 * cc + 2] + bflo(r1.y), oA1[4 * cc + 3] + bfhi(r1.y));
                *(LAS u32x2*)(prowA + 16 * cc) = w0; *(LAS u32x2*)(prowA + 64 + 16 * cc) = w1;
                r0 = *(const LAS u32x2*)(prowB + 16 * cc); r1 = *(const LAS u32x2*)(prowB + 64 + 16 * cc);
                w0.x = cvtpk(oB0[4 * cc] + bflo(r0.x), oB0[4 * cc + 1] + bfhi(r0.x)); w0.y = cvtpk(oB0[4 * cc + 2] + bflo(r0.y), oB0[4 * cc + 3] + bfhi(r0.y));
                w1.x = cvtpk(oB1[4 * cc] + bflo(r1.x), oB1[4 * cc + 1] + bfhi(r1.x)); w1.y = cvtpk(oB1[4 * cc + 2] + bflo(r1.y), oB1[4 * cc + 3] + bfhi(r1.y));
                *(LAS u32x2*)(prowB + 16 * cc) = w0; *(LAS u32x2*)(prowB + 64 + 16 * cc) = w1;
            }
            if (hi == 0) { L1[lrowA] = lsA; L1[lrowB] = lsB; }
        }
        __syncthreads();
#define FINALIZE_ITEM(r_, P0_) do { lsum += __shfl_xor(lsum, 32); const int lrow = (r_) + 16 * qi; lsum += L1[lrow]; const LAS char* prow = O1 + lrow * O1S + 8 * hi; \
            _Pragma("unroll") for (int c = 0; c < 4; ++c) { const u32x2 w0 = *(const LAS u32x2*)(prow + 16 * c), w1 = *(const LAS u32x2*)(prow + 64 + 16 * c); \
                o0[4 * c] += bflo(w0.x); o0[4 * c + 1] += bfhi(w0.x); o0[4 * c + 2] += bflo(w0.y); o0[4 * c + 3] += bfhi(w0.y); \
                o1[4 * c] += bflo(w1.x); o1[4 * c + 1] += bfhi(w1.x); o1[4 * c + 2] += bflo(w1.y); o1[4 * c + 3] += bfhi(w1.y); } \
            store_out(o0, o1, 1.0f / lsum, AO + (size_t)(seq_row + (P0_)) * 1024 + h * 64, (size_t)16 * 1024, vimg, lane); } while (0)
        {
            const int P0 = pc + wave;
            f32x16 o0, o1; float lsum = 0.f;
#pragma unroll
            for (int rr = 0; rr < 16; ++rr) { o0[rr] = 0.f; o1[rr] = 0.f; }
            run_branch1(o0, o1, lsum, qA, kb_, vb_, P0 & 15, 4, S >> 4, (P0 >> 4) - 64, kn, vn, vimg, lane);
            { const int P0d = pc + wave + 8;
              QLD(qB, h, seq_row + P0d + 16 * qi); pre_kv(kn, vn, kb_, vb_, (P0d >> 4) - 64, S >> 4, P0d & 15, 4, lane); }
            FINALIZE_ITEM(wave, P0);
        }
        {
            const int P0 = pc + wave + 8;
            f32x16 o0, o1; float lsum = 0.f;
#pragma unroll
            for (int rr = 0; rr < 16; ++rr) { o0[rr] = 0.f; o1[rr] = 0.f; }
            run_branch1(o0, o1, lsum, qB, kb_, vb_, P0 & 15, 4, S >> 4, (P0 >> 4) - 64, kn, vn, vimg, lane);
            if (u + G < N_UNITS_A) { UNIT_PARAMS(u + G, hn, Sn, srn, pcn, kbn, vbn); const int P0n = pcn + 64 * wave;
                QLD(qA, hn, srn + P0n + qi); QLD(qB, hn, srn + P0n + 32 + qi); pre_kv(kn, vn, kbn, vbn, P0n - 64, Sn, 0, 0, lane); }
            FINALIZE_ITEM(wave + 8, P0);
        }
#undef FINALIZE_ITEM
        __syncthreads();
    }
#undef QLD
#undef UNIT_PARAMS
    }
    {
        constexpr int KVB = 2 * VIMG_BYTES;
        constexpr int N_UNITS_B = 2 * (M / 64), UPW = 12;
        static_assert(10 * KVB + NWAVES * VIMG_BYTES <= LDS_BYTES, "mixer B LDS map");
        const int tid = wave * 64 + lane, chunk = tid & 7, r0 = tid >> 3;
        LAS char* kvw = (LAS char*)lds + (r0 >> 5) * KVB + (r0 & 31) * VS + chunk * 16;
        const int tile = wave >> 2, hq = wave & 3;
        const LAS char* krd = (const LAS char*)lds + (lane & 31) * VS + hi * 16;
        const LAS char* vrd = (const LAS char*)lds + VIMG_BYTES + (4 * hi + ((lane & 15) >> 2)) * VS + ((lane >> 4) & 1) * 32 + (lane & 3) * 8;
        u32x4 rk[5], rv[5]; bf16x8 qn[4];
        auto unit_ptrs = [&](int u, int& g, int& p0, int& S, int& seq_row) { g = u / (M / 64); const int row0 = (u % (M / 64)) * 64; S = row0 < ROWS_P ? SEQ_P : SEQ_S; seq_row = row0 & ~(S - 1); p0 = row0 - seq_row; };
        const int u_begin = (G == 256) ? vcu * UPW : vcu, u_step = (G == 256) ? 1 : G, u_count = (G == 256) ? UPW : (N_UNITS_B - vcu + G - 1) / G;
#define MB_LOAD(u) do { int g_, p0_, S_, sr_; unit_ptrs((u), g_, p0_, S_, sr_); const bf16* kb2 = QKV + (32 + g_) * HS + rofs(sr_) + chunk * 8; \
        { const bf16* qp_ = QKV + (24 + 4 * g_ + hq) * HS + rofs(sr_ + p0_ + 32 * tile + qi) + 8 * hi; _Pragma("unroll") for (int s = 0; s < 4; ++s) qn[s] = *(const bf16x8*)(qp_ + 16 * s); } \
        _Pragma("unroll") for (int j = 0; j < 5; ++j) { int l = p0_ - 128 + r0 + 64 * j; l = l < 0 ? 0 : (l > S_ - 1 ? S_ - 1 : l); \
            rk[j] = *(const u32x4*)(kb2 + rofs(l)); rv[j] = *(const u32x4*)(kb2 + 2 * HS + rofs(l)); } } while (0)
        for (int rep = 0; rep < ATT_REP_B; ++rep) {
        if (u_count > 0) MB_LOAD(u_begin);
#pragma unroll 1
        for (int ui = 0; ui < u_count; ++ui) {
            const int u = u_begin + ui * u_step;
            int g, p0, S, seq_row; unit_ptrs(u, g, p0, S, seq_row);
#pragma unroll
            for (int j = 0; j < 5; ++j) { *(LAS u32x4*)(kvw + 2 * j * KVB) = rk[j]; *(LAS u32x4*)(kvw + 2 * j * KVB + VIMG_BYTES) = rv[j]; }
            __syncthreads();
            bf16x8 qf[4];
#pragma unroll
            for (int s = 0; s < 4; ++s) qf[s] = qn[s];
            if (ui + 1 < u_count) MB_LOAD(u + u_step);
            const int hb = 4 * g + hq, P0 = p0 + 32 * tile;
            const size_t qrow = (size_t)(seq_row + P0 + qi);
            f32x16 o0, o1; float lsum = (hi == 0) ? __builtin_amdgcn_exp2f(sink[hb] * 1.4426950408889634f) : 0.f;
#pragma unroll
            for (int r = 0; r < 16; ++r) { o0[r] = 0.f; o1[r] = 0.f; }
            const int lstart = P0 - 128;
            const int b_lo = (lstart < -31) ? ((-lstart) >> 5) : 0;
            int b_hi = (S - lstart + 31) >> 5; if (b_hi > 9) b_hi = 9;
            const int tq = qi - 4 * hi;
#define MB_QK(b, scv, vfv) do { \
                const LAS char* kp = krd + ((b) + tile) * KVB; \
                bf16x8 kf[4]; \
                _Pragma("unroll") for (int s = 0; s < 4; ++s) kf[s] = *(const LAS bf16x8*)(kp + 32 * s); \
                scv = qk(kf, qf); \
                const LAS char* vr = vrd + ((b) + tile) * KVB; \
                vfv[0] = ATT_VF(0, 0); vfv[1] = ATT_VF(0, 1); vfv[2] = ATT_VF(1, 0); vfv[3] = ATT_VF(1, 1); } while (0)
#define MB_FIN(b, scv, vfv) do { \
                const int l0 = lstart + 32 * (b); \
                const bool safe_ = ((b) >= 1) && ((b) <= 7) && (l0 >= 0) && (l0 + 31 < S); \
                if (!safe_) { \
                    const int tb = 32 * (b) - tq, lb = l0 + 4 * hi; \
                    _Pragma("unroll") for (int r = 0; r < 16; ++r) { \
                        const int cr = (r & 3) + 8 * (r >> 2); \
                        const bool ok = ((unsigned)(tb + cr) <= 256u) && ((unsigned)(lb + cr) < (unsigned)S); \
                        scv[r] = ok ? scv[r] : -INFINITY; } } \
                float p[16]; \
                _Pragma("unroll") for (int r = 0; r < 16; ++r) { p[r] = __builtin_amdgcn_exp2f(scv[r]); lsum += p[r]; } \
                u32x4 pw0, pw1; \
                pw0.x = cvtpk(p[0], p[1]); pw0.y = cvtpk(p[2], p[3]); pw0.z = cvtpk(p[4], p[5]); pw0.w = cvtpk(p[6], p[7]); \
                pw1.x = cvtpk(p[8], p[9]); pw1.y = cvtpk(p[10], p[11]); pw1.z = cvtpk(p[12], p[13]); pw1.w = cvtpk(p[14], p[15]); \
                const bf16x8 pf0 = __builtin_bit_cast(bf16x8, pw0), pf1 = __builtin_bit_cast(bf16x8, pw1); \
                o0 = __builtin_amdgcn_mfma_f32_32x32x16_bf16(vfv[0], pf0, o0, 0, 0, 0); \
                o1 = __builtin_amdgcn_mfma_f32_32x32x16_bf16(vfv[1], pf0, o1, 0, 0, 0); \
                o0 = __builtin_amdgcn_mfma_f32_32x32x16_bf16(vfv[2], pf1, o0, 0, 0, 0); \
                o1 = __builtin_amdgcn_mfma_f32_32x32x16_bf16(vfv[3], pf1, o1, 0, 0, 0); } while (0)
#define ATT_VF(t, d0) __builtin_shufflevector(vtr(vr + (16 * (t)) * VS + 64 * (d0)), vtr(vr + (16 * (t) + 8) * VS + 64 * (d0)), 0, 1, 2, 3, 4, 5, 6, 7)
            {
                f32x16 scA, scB; bf16x8 vfA[4], vfB[4];
                int b = b_lo;
                MB_QK(b, scA, vfA);
#pragma unroll 1
                for (; b + 1 < b_hi; b += 2) {
                    MB_QK(b + 1, scB, vfB);
                    MB_FIN(b, scA, vfA);
                    if (b + 2 < b_hi) MB_QK(b + 2, scA, vfA);
                    MB_FIN(b + 1, scB, vfB);
                }
                if (b < b_hi) MB_FIN(b, scA, vfA);
            }
#undef ATT_VF
#undef MB_QK
#undef MB_FIN
            lsum += __shfl_xor(lsum, 32);
            store_out(o0, o1, 1.0f / lsum, AO + (size_t)(seq_row + P0) * 1024 + 512 + hb * 64, (size_t)1024, (LAS char*)lds + 10 * KVB + wave * VIMG_BYTES, lane);
            __syncthreads();
        }
        }
#undef MB_LOAD
    }
}
}

#define XB_TMO      128
#define XB_XCNT(j)  (256  + 64 * (j))
#define XB_XSUB(j)  (1280 + 64 * (j))
#define XB_XGEN(j)  (2304 + 64 * (j))
#define XB_TOP      3328
#define XB_TOPGEN   3392
#define XCD_BAR_WORDS 3456
#define XB_SPIN_CAP (1u << 18)

__device__ __forceinline__ unsigned xb_ld(unsigned* p)              { return __hip_atomic_load(p, __ATOMIC_RELAXED, __HIP_MEMORY_SCOPE_AGENT); }
__device__ __forceinline__ unsigned xb_add(unsigned* p, unsigned v) { return __hip_atomic_fetch_add(p, v, __ATOMIC_RELAXED, __HIP_MEMORY_SCOPE_AGENT); }
__device__ __forceinline__ unsigned xb_xcc_id() { return (unsigned)__builtin_amdgcn_s_getreg((3 << 11) | 20) & 0xFu; }
#define XB_SPIN(cond, bar) do { unsigned _sp = 0; while (cond) { __builtin_amdgcn_s_sleep(1); \
    if ((++_sp & 255u) == 0u) { if (xb_ld(&(bar)[XB_TMO])) break; if (_sp > XB_SPIN_CAP) { atomicAdd(&(bar)[XB_TMO], 1u); break; } } } } while (0)

struct XcdBarrier {
    unsigned* bar; unsigned x;
    volatile LAS unsigned* st;
};

__device__ __forceinline__ XcdBarrier xcd_barrier_post(unsigned* bar, volatile LAS unsigned* st) {
    XcdBarrier b; b.bar = bar; b.x = xb_xcc_id(); b.st = st;
    if (threadIdx.x == 0) (void)xb_add(&bar[XB_XCNT(b.x)], 1u);
    return b;
}
__device__ __forceinline__ void xcd_barrier_complete(unsigned* bar, unsigned x, unsigned& nloc, unsigned& nx) {
    const unsigned G = gridDim.x * gridDim.y * gridDim.z;
    unsigned sum, cnt, mine, sp = 0u;
    for (;;) {
        sum = 0u; cnt = 0u; mine = 0u;
#pragma unroll
        for (unsigned j = 0; j < 16; ++j) { const unsigned c = xb_ld(&bar[XB_XCNT(j)]); sum += c; cnt += (c > 0u) ? 1u : 0u; mine = (j == x) ? c : mine; }
        if (sum == G) break;
        __builtin_amdgcn_s_sleep(1);
        if ((++sp & 255u) == 0u) { if (xb_ld(&bar[XB_TMO])) break; if (sp > XB_SPIN_CAP) { atomicAdd(&bar[XB_TMO], 1u); break; } }
    }
    nloc = mine > 0u ? mine : 1u; nx = cnt > 0u ? cnt : 1u;
}

__device__ __forceinline__ void xcd_barrier(const XcdBarrier& b) {
    asm volatile("s_waitcnt vmcnt(0)" ::: "memory");
    __syncthreads();
    if (threadIdx.x == 0) {
        unsigned* bar = b.bar;
        __builtin_amdgcn_s_waitcnt(0);
        unsigned nloc = b.st[0], nx = b.st[1];
        if (nloc == 0u) { xcd_barrier_complete(bar, b.x, nloc, nx); b.st[0] = nloc; b.st[1] = nx; }
        const unsigned old = xb_add(&bar[XB_XSUB(b.x)], 1u);
        const unsigned gen = old / nloc;
        if (old + 1u == (gen + 1u) * nloc) {
            __builtin_amdgcn_fence(__ATOMIC_RELEASE, "agent");
            asm volatile("s_waitcnt vmcnt(0)" ::: "memory");
            const unsigned og = xb_add(&bar[XB_TOP], 1u);
            const unsigned tg = og / nx;
            if (og + 1u == (tg + 1u) * nx) xb_add(&bar[XB_TOPGEN], 1u);
            else XB_SPIN(xb_ld(&bar[XB_TOPGEN]) == tg, bar);
            __builtin_amdgcn_fence(__ATOMIC_ACQUIRE, "agent");
            xb_add(&bar[XB_XGEN(b.x)], 1u);
            asm volatile("s_waitcnt vmcnt(0)" ::: "memory");
        } else {
            XB_SPIN(xb_ld(&bar[XB_XGEN(b.x)]) == gen, bar);
            __builtin_amdgcn_fence(__ATOMIC_ACQUIRE, "agent");
            asm volatile("s_waitcnt vmcnt(0)" ::: "memory");
        }
    }
    __syncthreads();
}

struct Args { const float* in[14]; float* out; unsigned char* ws; int ph_lo, ph_hi; };
__global__ void __launch_bounds__(NWAVES * 64, 2) hymba_fwd(Args args) {
    extern __shared__ __attribute__((aligned(16))) unsigned char lds_raw[];
    cg::grid_group grid = cg::this_grid();
    LAS unsigned char* lds = (LAS unsigned char*)lds_raw;
    const int tid = threadIdx.x, lane = tid & 63, wave = __builtin_amdgcn_readfirstlane(tid >> 6);
    const int G = gridDim.x, bx = blockIdx.x;
    const int vcu = (G % 8 == 0) ? (bx % 8) * (G / 8) + bx / 8 : bx;
    const int gw = vcu * NWAVES + wave, NGW = G * NWAVES;
    unsigned char* ws = args.ws;
    const float* xp = args.in[0]; const float* xs = args.in[1]; const float* attn_norm = args.in[2]; const float* w_in = args.in[3];
    const float* qnorm_a = args.in[4]; const float* knorm_a = args.in[5]; const float* qnorm_b = args.in[6]; const float* knorm_b = args.in[7];
    const float* sink_b = args.in[8]; const float* w_out = args.in[9]; const float* ffn_norm = args.in[10]; const float* w_gate = args.in[11];
    const float* w_up = args.in[12]; const float* w_down = args.in[13];
    float* rowss = (float*)(ws + WS_ROWSS); float* cosT = (float*)(ws + WS_COS); float* sinT = (float*)(ws + WS_SIN);
    bf16* Win_t = (bf16*)(ws + WS_WIN); bf16* Wout_t = (bf16*)(ws + WS_WOUT); bf16* Wgu_t = (bf16*)(ws + WS_WGU); bf16* Wdn_t = (bf16*)(ws + WS_WDN);
    bf16* XN = (bf16*)(ws + WS_XN); bf16* AO = XN; bf16* QKV = (bf16*)(ws + WS_QKV); bf16* HB = (bf16*)(ws + WS_H); bf16* XB = (bf16*)(ws + WS_XB);
    const int lo = args.ph_lo, hi = args.ph_hi;
    volatile LAS unsigned* bst = (volatile LAS unsigned*)(lds + LDS_BYTES - 64);
    if (tid < 16) ((LAS unsigned*)(lds + LDS_BYTES - 64))[tid] = 0u;
    __syncthreads();
    XcdBarrier xbar = xcd_barrier_post((unsigned*)(ws + WS_BAR), bst);
    if (lo < 0) grid.sync();
#define IN(k) (lo <= (k) && (k) < hi)
#define SEAM(k) do { if (IN(k) && IN((k) + 1)) xcd_barrier(xbar); } while (0)

    if (IN(0)) {
        LAS float* scr = (LAS float*)(lds + wave * 16384);
        constexpr int I_IN = 16 * 72, I_OUT = 16 * 32, I_G = 16 * 88, I_D = 44 * 32, NITEMS = I_IN + I_OUT + 2 * I_G + I_D;
        for (int it = gw; it < NITEMS; it += NGW) {
            int r = it;
            if (r < I_IN) { const int kb = r / 72, nb = r % 72, n0 = nb * 32; const int dst = 256 * (n0 >> 8) + 128 * ((n0 & 63) >> 5) + 32 * ((n0 & 255) >> 6);
                p0_transpose_item(w_in, D, NIN, Win_t, dst, nullptr, scr, kb, nb, lane); continue; } r -= I_IN;
            if (r < I_OUT) { const int kb = r / 32, nb = r % 32; p0_transpose_item(w_out, D, D, Wout_t, nb * 32, nullptr, scr, kb, nb, lane); continue; } r -= I_OUT;
            if (r < I_G) { const int kb = r / 88, nb = r % 88, n0 = nb * 32; p0_transpose_item(w_gate, D, DFF, Wgu_t, 256 * (n0 >> 7) + (n0 & 127), ffn_norm, scr, kb, nb, lane); continue; } r -= I_G;
            if (r < I_G) { const int kb = r / 88, nb = r % 88, n0 = nb * 32; p0_transpose_item(w_up, D, DFF, Wgu_t, 256 * (n0 >> 7) + 128 + (n0 & 127), ffn_norm, scr, kb, nb, lane); continue; } r -= I_G;
            { const int kb = r / 32, nb = r % 32; p0_transpose_item(w_down, DFF, D, Wdn_t, nb * 32, nullptr, scr, kb, nb, lane); }
        }
        const int gt = gw * 64 + lane, NGT = NGW * 64;
        for (int i = gt; i < SEQ_P * 32; i += NGT) { float c, s; rope_entry(i >> 5, i & 31, c, s); cosT[i] = c; sinT[i] = s; }
        for (int i = gt; i < M; i += NGT) rowss[i] = 0.f;
        for (int m0 = gw; m0 < M; m0 += 4 * NGW) {
            f32x4 v[4][4]; float ssq[4];
#pragma unroll
            for (int q = 0; q < 4; ++q) { const int m = m0 + q * NGW; const int mm = m < M ? m : M - 1;
                const float* xrow = mm < ROWS_P ? xp + (size_t)mm * D : xs + (size_t)(mm - ROWS_P) * D;
                const f32x4* xr = (const f32x4*)xrow + lane;
#pragma unroll
                for (int j = 0; j < 4; ++j) v[q][j] = __builtin_nontemporal_load(xr + 64 * j); }
            const f32x4* gr = (const f32x4*)attn_norm + lane;
#pragma unroll
            for (int q = 0; q < 4; ++q) { float s = 0.f;
#pragma unroll
                for (int j = 0; j < 4; ++j) s += (v[q][j].x * v[q][j].x + v[q][j].y * v[q][j].y) + (v[q][j].z * v[q][j].z + v[q][j].w * v[q][j].w);
                ssq[q] = s; }
#pragma unroll
            for (int q = 0; q < 4; ++q) { const int m = m0 + q * NGW; if (m >= M) continue;
                const float rstd = 1.f / sqrtf(wave_sum(ssq[q]) * (1.f / D) + 1e-6f);
                unsigned long long* o8 = (unsigned long long*)(XN + (size_t)m * D) + lane;
#pragma unroll
                for (int j = 0; j < 4; ++j) { const f32x4 g = gr[64 * j]; o8[64 * j] = (unsigned long long)pk2(v[q][j].x * rstd * g.x, v[q][j].y * rstd * g.y) | ((unsigned long long)pk2(v[q][j].z * rstd * g.z, v[q][j].w * rstd * g.w) << 32); } }
        }
        __syncthreads();
    }
    SEAM(0);
    if (IN(1)) {
        pg8::Gemm g{XN, Win_t, M, NIN, D}; pg8::StaticOrder S; S.init(M, NIN, G, bx);
        pg8::EpiQKV E{QKV, cosT, sinT, qnorm_a, knorm_a, qnorm_b, knorm_b};
        pg8::gemm_phase<pg8::EpiQKV, pg8::StaticOrder, PG8_ALIGN, PG8_SP2>(lds, g, S, E);
    }
    SEAM(1);
    if (IN(2)) att::attention_phase(QKV, AO, sink_b, lds, vcu, G, wave, lane);
    SEAM(2);
    if (IN(3)) {
        pg8::Gemm g{AO, Wout_t, M, D, D}; pg8::StaticOrder S; S.init(M, D, G, bx);
        pg8::EpiOut E{xp, xs, XB, rowss};
        pg8::gemm_phase<pg8::EpiOut, pg8::StaticOrder, PG8_ALIGN, PG8_SP2>(lds, g, S, E);
    }
    SEAM(3);
    if (IN(4)) {
        pg8::Gemm g{XB, Wgu_t, M, NGU, D}; pg8::StaticOrder S; S.init(M, NGU, G, bx);
        pg8::EpiGU E{HB, rowss};
        pg8::gemm_phase<pg8::EpiGU, pg8::StaticOrder, PG8_ALIGN, PG8_SP2>(lds, g, S, E);
    }
    SEAM(4);
    if (IN(5)) {
        pg8::Gemm g{HB, Wdn_t, M, D, DFF}; pg8::StaticOrder S; S.init(M, D, G, bx);
        pg8::EpiDown E{args.out, XB};
        pg8::gemm_phase<pg8::EpiDown, pg8::StaticOrder, PG8_ALIGN, PG8_SP2>(lds, g, S, E);
    }
#undef IN
#undef SEAM
}

#ifndef MK_N_LAUNCHES
#define MK_N_LAUNCHES 1
#endif
extern "C" void kernel_launch(void* const* d_in, const int* in_sizes, int n_in, void* d_out, int out_size, void* d_ws, size_t ws_size, hipStream_t stream) {
    static int grid = 0;
    if (grid == 0) {
        if (n_in != 14 || out_size != M * D || ws_size < WS_END) { fprintf(stderr, "kernel_launch: unexpected shapes (n_in %d, out %d, ws %zu); nothing launched\n", n_in, out_size, ws_size); grid = -1; return; }
        int dev = 0, cus = 0, per_cu = 0;
        if (hipGetDevice(&dev) != hipSuccess || hipDeviceGetAttribute(&cus, hipDeviceAttributeMultiprocessorCount, dev) != hipSuccess) { grid = -1; return; }
        if (hipFuncSetAttribute((const void*)hymba_fwd, hipFuncAttributeMaxDynamicSharedMemorySize, LDS_BYTES) != hipSuccess) { fprintf(stderr, "kernel_launch: hipFuncSetAttribute failed\n"); grid = -1; return; }
        if (hipOccupancyMaxActiveBlocksPerMultiprocessor(&per_cu, (const void*)hymba_fwd, NWAVES * 64, LDS_BYTES) != hipSuccess || per_cu < 1) { fprintf(stderr, "kernel_launch: occupancy query says %d\n", per_cu); per_cu = 1; }
        (void)hipGetLastError();
        grid = cus * 1;
    }
    if (grid < 0) return;
    if (hipMemsetAsync((char*)d_ws + WS_BAR, 0, WS_BAR_BYTES, stream) != hipSuccess) { fprintf(stderr, "kernel_launch: hipMemsetAsync of the barrier words failed; nothing launched\n"); return; }
    Args a{};
    for (int i = 0; i < 14; ++i) a.in[i] = (const float*)d_in[i];
    a.out = (float*)d_out; a.ws = (unsigned char*)d_ws;
    for (int li = 0; li < MK_N_LAUNCHES; ++li) {
        if (MK_N_LAUNCHES == 1) { a.ph_lo = 0; a.ph_hi = 6; } else { a.ph_lo = li; a.ph_hi = li + 1; }
        void* kargs[] = {&a};
        const hipError_t e = hipLaunchCooperativeKernel((const void*)hymba_fwd, dim3(grid), dim3(NWAVES * 64), kargs, LDS_BYTES, stream);
        if (e != hipSuccess) { fprintf(stderr, "kernel_launch: cooperative launch %d failed: %s (grid %d)\n", li, hipGetErrorString(e), grid); break; }
    }
}
```

```cpp
#include <hip/hip_runtime.h>
#include <hip/hip_cooperative_groups.h>
#include <cstdio>
#include <cstdint>
namespace cg = cooperative_groups;
namespace pg8 {
#define PG8_LAS __attribute__((address_space(3)))
typedef unsigned short bf16_t;
typedef short bf16x8 __attribute__((ext_vector_type(8)));
typedef float f32x4 __attribute__((ext_vector_type(4)));
typedef unsigned u32x4 __attribute__((ext_vector_type(4)));
constexpr int BM = 256, BK = 64, HALF = 128, HTB = HALF * BK * 2  , STAGE_BYTES = 8 * HTB, NXCD = 8, WGM = 8;

__host__ __device__ __forceinline__ int lds_byte(int r, int c) { const int st = (r >> 4) * 2 + (c >> 5), rr = r & 15, cc = c & 31, ob = rr * 64 + cc * 2; return st * 1024 + (ob ^ (((ob >> 9) & 1) << 5)); }
__host__ __device__ __forceinline__ void stage_rc(int b, int& R, int& C) { const int st = b / 1024, sb = b % 1024, swz = sb ^ (((sb >> 9) & 1) << 5); R = (st >> 1) * 16 + swz / 64; C = (st & 1) * 32 + (swz % 64) / 2; }
__host__ __device__ __forceinline__ int perm32(int rho) { const int n = rho >> 4, i = rho & 15; return 8 * (i >> 2) + 4 * n + (i & 3); }

struct Unit { int pm, pn; };
struct Gemm { const bf16_t* A; const bf16_t* Bt; int M, N, K; };

struct StaticOrder {
    int nM, nN, nwg, G, c;
    __host__ __device__ void init(int M, int N, int G_, int c_) { nM = M / BM; nN = N / BM; nwg = nM * nN; G = G_; c = c_; }
    __host__ __device__ bool next(int i, Unit& u) const {
        const long L = (long)i * G + c; if (L >= nwg) return false;
        int wgid = (int)L; { const int q = nwg / NXCD, r = nwg % NXCD, xcd = wgid % NXCD, off = wgid / NXCD; wgid = (xcd < r ? xcd * (q + 1) : r * (q + 1) + (xcd - r) * q) + off; }
        const int nig = WGM * nN, gid = wgid / nig, fm = gid * WGM, gsz = (nM - fm) < WGM ? (nM - fm) : WGM;
        u.pm = fm + ((wgid % nig) % gsz); u.pn = (wgid % nig) / gsz; return true;
    }
    __device__ __forceinline__ void a_ready(const Unit&) const {}
    __device__ __forceinline__ void done(const Unit&) const {}
};

typedef float f32x2 __attribute__((ext_vector_type(2)));
typedef __bf16 bf16x2v __attribute__((ext_vector_type(2)));
__device__ __forceinline__ unsigned cvt_pk_bf16(float lo, float hi) { f32x2 v = {lo, hi}; bf16x2v b = __builtin_convertvector(v, bf16x2v); return __builtin_bit_cast(unsigned, b); }
template <class Epi, class Sched, bool ALIGN_EPI = false, bool SP2 = false>
__device__ __forceinline__ void gemm_phase(PG8_LAS unsigned char* lds, const Gemm g, const Sched& S, const Epi& E) {
    const int tid = threadIdx.x, wid = __builtin_amdgcn_readfirstlane(tid >> 6), lane = tid & 63, wr = wid >> 2, wc = wid & 3, fr = lane & 15, fq = lane >> 4;
    const int K = g.K, nt = K / BK;
    unsigned voffA[2], voffB[2];
#pragma unroll
    for (int i = 0; i < 2; ++i) { int R, C; stage_rc(tid * 16 + i * 8192, R, C); const int Rb = Epi::PERM ? ((R & ~31) + perm32(R & 31)) : R;
        voffA[i] = (unsigned)(R * K + C) * 2u; voffB[i] = (unsigned)(Rb * K + C) * 2u; }
    const size_t kstep = (size_t)(BK * 2);
    const size_t hstep = (size_t)HALF * K * 2;
    const size_t tstep = 2 * hstep;
    const unsigned ldsw = (unsigned)wid * 1024u;
    const int aoff = lds_byte(wr * 64 + fr, fq * 8), boff = lds_byte(wc * 32 + fr, fq * 8);
#define PG8_SA(b, h) (((b) * 2 + (h)) * HTB)
#define PG8_SB(b, h) ((4 + (b) * 2 + (h)) * HTB)
#define PG8_STAGE(bufoff, gbase, voff) do { _Pragma("unroll") for (int _i = 0; _i < 2; ++_i) \
        __builtin_amdgcn_global_load_lds((const unsigned*)((const char*)(gbase) + (voff)[_i]), (PG8_LAS unsigned*)(lds + (bufoff) + ldsw + _i * 8192), 16, 0, 0); } while (0)
#define PG8_LDA(dst, b, h) do { _Pragma("unroll") for (int m = 0; m < 4; ++m) _Pragma("unroll") for (int k = 0; k < 2; ++k) dst[m][k] = *(const PG8_LAS bf16x8*)(lds + PG8_SA(b, h) + aoff + m * 2048 + k * 1024); } while (0)
#define PG8_LDB(dst, b, h) do { _Pragma("unroll") for (int n = 0; n < 2; ++n) _Pragma("unroll") for (int k = 0; k < 2; ++k) dst[n][k] = *(const PG8_LAS bf16x8*)(lds + PG8_SB(b, h) + boff + n * 2048 + k * 1024); } while (0)
#define PG8_MMA(ai, bj, At, Bt) do { __builtin_amdgcn_s_setprio(1); _Pragma("unroll") for (int m = 0; m < 4; ++m) _Pragma("unroll") for (int n = 0; n < 2; ++n) _Pragma("unroll") for (int k = 0; k < 2; ++k) \
        acc[ai][bj][m][n] = __builtin_amdgcn_mfma_f32_16x16x32_bf16(Bt[n][k], At[m][k], acc[ai][bj][m][n], 0, 0, 0); __builtin_amdgcn_s_setprio(0); } while (0)
#define PG8_WAIT_V(n) asm volatile("s_waitcnt vmcnt(" #n ")" ::: "memory")
#define PG8_WAIT_L(n) asm volatile("s_waitcnt lgkmcnt(" #n ")" ::: "memory")
#define PG8_BAR __builtin_amdgcn_s_barrier()
#define PG8_SCHED __builtin_amdgcn_sched_barrier(0)
    Unit cur, nxt; int ui = 0;
    if (!S.next(0, cur)) return;
    f32x4 acc[2][2][4][2];
#pragma unroll
    for (int a = 0; a < 2; ++a)
#pragma unroll
        for (int b = 0; b < 2; ++b)
#pragma unroll
            for (int m = 0; m < 4; ++m)
#pragma unroll
                for (int n = 0; n < 2; ++n) acc[a][b][m][n] = (f32x4){0.f, 0.f, 0.f, 0.f};
    bf16x8 At[4][2], B0[2][2], B1[2][2];
    const char* cA = (const char*)g.A + (size_t)cur.pm * tstep; const char* cB = (const char*)g.Bt + (size_t)cur.pn * tstep;
    S.a_ready(cur);
    if constexpr (SP2) {
        PG8_STAGE(PG8_SB(0, 0), cB, voffB); PG8_STAGE(PG8_SB(0, 1), cB + hstep, voffB); PG8_STAGE(PG8_SA(0, 0), cA, voffA); PG8_STAGE(PG8_SA(0, 1), cA + hstep, voffA);
        if (wr == 1) PG8_BAR;
        PG8_WAIT_V(2); PG8_BAR;
        PG8_STAGE(PG8_SB(1, 0), cB + kstep, voffB); PG8_STAGE(PG8_SA(1, 0), cA + kstep, voffA); PG8_STAGE(PG8_SB(1, 1), cB + hstep + kstep, voffB);
        PG8_WAIT_V(6); PG8_BAR;
    } else {
        PG8_STAGE(PG8_SB(0, 0), cB, voffB); PG8_STAGE(PG8_SA(0, 0), cA, voffA); PG8_STAGE(PG8_SB(0, 1), cB + hstep, voffB); PG8_STAGE(PG8_SA(0, 1), cA + hstep, voffA);
        if (wr == 1) PG8_BAR;
        PG8_WAIT_V(4); PG8_BAR;
        PG8_STAGE(PG8_SB(1, 0), cB + kstep, voffB); PG8_STAGE(PG8_SA(1, 0), cA + kstep, voffA); PG8_STAGE(PG8_SB(1, 1), cB + hstep + kstep, voffB);
        PG8_WAIT_V(6); PG8_BAR;
    }
    for (;;) {
        const bool has_next = S.next(ui + 1, nxt);
        const char* nA = has_next ? (const char*)g.A + (size_t)nxt.pm * tstep : cA; const char* nB = has_next ? (const char*)g.Bt + (size_t)nxt.pn * tstep : cB;
        for (int t = 0; t < nt; t += 2) {
            const bool last = (t == nt - 2);
            const char* a1 = cA + (size_t)(t + 1) * kstep;
            const char* a2 = last ? nA : cA + (size_t)(t + 2) * kstep; const char* b2 = last ? nB : cB + (size_t)(t + 2) * kstep;
            const char* a3 = a2 + kstep; const char* b3 = b2 + kstep;
            if (last && has_next) S.a_ready(nxt);
            if constexpr (SP2) {
            PG8_LDB(B0, 0, 0); PG8_LDB(B1, 0, 1); PG8_SCHED; PG8_LDA(At, 0, 0); PG8_STAGE(PG8_SA(1, 1), a1 + hstep, voffA);
            PG8_WAIT_V(8); PG8_WAIT_L(0); PG8_BAR; PG8_MMA(0, 0, At, B0); PG8_MMA(0, 1, At, B1); PG8_BAR; PG8_SCHED;
            PG8_LDA(At, 0, 1); PG8_STAGE(PG8_SB(0, 0), b2, voffB); PG8_STAGE(PG8_SB(0, 1), b2 + hstep, voffB); PG8_STAGE(PG8_SA(0, 0), a2, voffA);
            PG8_WAIT_V(8); PG8_WAIT_L(0); PG8_BAR; PG8_MMA(1, 0, At, B0); PG8_MMA(1, 1, At, B1); PG8_BAR; PG8_SCHED;
            PG8_LDB(B0, 1, 0); PG8_LDB(B1, 1, 1); PG8_SCHED; PG8_LDA(At, 1, 0); PG8_STAGE(PG8_SA(0, 1), a2 + hstep, voffA);
            PG8_WAIT_V(8); PG8_WAIT_L(0); PG8_BAR; PG8_MMA(0, 0, At, B0); PG8_MMA(0, 1, At, B1); PG8_BAR; PG8_SCHED;
            PG8_LDA(At, 1, 1); PG8_STAGE(PG8_SB(1, 0), b3, voffB); PG8_STAGE(PG8_SB(1, 1), b3 + hstep, voffB); PG8_STAGE(PG8_SA(1, 0), a3, voffA);
            PG8_WAIT_V(8); PG8_WAIT_L(0); PG8_BAR; PG8_MMA(1, 0, At, B0); PG8_MMA(1, 1, At, B1); PG8_BAR; PG8_SCHED;
            } else {
            PG8_LDB(B0, 0, 0); PG8_SCHED; PG8_LDA(At, 0, 0); PG8_STAGE(PG8_SA(1, 1), a1 + hstep, voffA);
            PG8_WAIT_L(8); PG8_BAR; PG8_WAIT_L(0); PG8_MMA(0, 0, At, B0); PG8_BAR; PG8_SCHED;
            PG8_LDB(B1, 0, 1); PG8_STAGE(PG8_SB(0, 0), b2, voffB);
            PG8_BAR; PG8_WAIT_L(0); PG8_MMA(0, 1, At, B1); PG8_BAR;
            PG8_LDA(At, 0, 1); PG8_STAGE(PG8_SA(0, 0), a2, voffA);
            PG8_BAR; PG8_WAIT_L(0); PG8_MMA(1, 0, At, B0); PG8_BAR; PG8_SCHED;
            PG8_STAGE(PG8_SB(0, 1), b2 + hstep, voffB);
            PG8_WAIT_V(6); PG8_BAR; PG8_MMA(1, 1, At, B1); PG8_BAR;
            PG8_LDB(B0, 1, 0); PG8_SCHED; PG8_LDA(At, 1, 0); PG8_STAGE(PG8_SA(0, 1), a2 + hstep, voffA);
            PG8_WAIT_L(8); PG8_BAR; PG8_WAIT_L(0); PG8_MMA(0, 0, At, B0); PG8_BAR; PG8_SCHED;
            PG8_LDB(B1, 1, 1); PG8_STAGE(PG8_SB(1, 0), b3, voffB);
            PG8_BAR; PG8_WAIT_L(0); PG8_MMA(0, 1, At, B1); PG8_BAR;
            PG8_LDA(At, 1, 1); PG8_STAGE(PG8_SA(1, 0), a3, voffA);
            PG8_BAR; PG8_WAIT_L(0); PG8_MMA(1, 0, At, B0); PG8_BAR; PG8_SCHED;
            PG8_STAGE(PG8_SB(1, 1), b3 + hstep, voffB);
            PG8_WAIT_V(6); PG8_BAR; PG8_MMA(1, 1, At, B1); PG8_BAR;
            }
        }
        if constexpr (ALIGN_EPI) { if (wr == 0) PG8_BAR; }
        if constexpr (!Epi::AFTER_DRAIN) { E(acc, cur, wr, wc, fr, fq); S.done(cur); }
        if (!has_next) break;
#pragma unroll
        for (int a = 0; a < 2; ++a)
#pragma unroll
            for (int b = 0; b < 2; ++b)
#pragma unroll
                for (int m = 0; m < 4; ++m)
#pragma unroll
                    for (int n = 0; n < 2; ++n) acc[a][b][m][n] = (f32x4){0.f, 0.f, 0.f, 0.f};
        cur = nxt; cA = nA; cB = nB; ++ui;
        if constexpr (ALIGN_EPI) { if (wr == 1) PG8_BAR; }
    }
    PG8_WAIT_V(0);
    if constexpr (!ALIGN_EPI) { if (wr == 0) PG8_BAR; }
    PG8_BAR;
    if constexpr (Epi::AFTER_DRAIN) { E.fused(acc, cur, wr, wc, fr, fq, lds, wid, lane); S.done(cur); }
#undef PG8_SA
#undef PG8_SB
#undef PG8_STAGE
#undef PG8_LDA
#undef PG8_LDB
#undef PG8_MMA
#undef PG8_WAIT_V
#undef PG8_WAIT_L
#undef PG8_BAR
#undef PG8_SCHED
}
}

namespace pg8 {
constexpr int ROWS_P = 32768, SEQ_P = 16384, SEQ_S = 2048;
constexpr float QSCALE = 0.125f * 1.4426950408889634f;
constexpr float NORM_EPS = 1e-6f;
constexpr size_t HS_QKV = (size_t)(98304 + 98304 / 16) * 64;
__device__ __forceinline__ float dot4(const f32x4 a) { return (a[0] * a[0] + a[1] * a[1]) + (a[2] * a[2] + a[3] * a[3]); }
__device__ __forceinline__ float rows4_sum(float v) {
    const unsigned u = __builtin_bit_cast(unsigned, v);
    auto a = __builtin_amdgcn_permlane16_swap(u, u, false, false);
    const float s16 = __builtin_bit_cast(float, (unsigned)a[0]) + __builtin_bit_cast(float, (unsigned)a[1]);
    const unsigned w = __builtin_bit_cast(unsigned, s16);
    auto b = __builtin_amdgcn_permlane32_swap(w, w, false, false);
    return __builtin_bit_cast(float, (unsigned)b[0]) + __builtin_bit_cast(float, (unsigned)b[1]);
}

struct EpiQKV {
    static constexpr bool PERM = true, AFTER_DRAIN = false;
    bf16_t* O; const float* cosT; const float* sinT; const float* gqa; const float* gka; const float* gqb; const float* gkb;
    __device__ __forceinline__ void operator()(const f32x4 (&acc)[2][2][4][2], const Unit& u, int wr, int wc, int fr, int fq) const {
        const int pn = u.pn;
        const float* g = nullptr; float sc = 1.f;
        if (pn < 2) { g = gqa; sc = QSCALE; } else if (pn < 4) { g = gka; } else if (pn < 6) { } else if (pn < 8) { g = gqb; sc = QSCALE; } else if (wc < 2) { g = gkb; }
        f32x4 gv[2][2];
#pragma unroll
        for (int bj = 0; bj < 2; ++bj)
#pragma unroll
            for (int n = 0; n < 2; ++n) gv[bj][n] = g ? *(const f32x4*)(g + 32 * bj + 8 * fq + 4 * n) : (f32x4){1.f, 1.f, 1.f, 1.f};
        f32x4 tb[1][4];
#define QKV_LDT(k, slot) do { if (g) { const int row_ = u.pm * BM + ((k) >> 2) * HALF + wr * 64 + ((k) & 3) * 16 + fr; const int pos_ = row_ < ROWS_P ? (row_ & (SEQ_P - 1)) : (row_ & (SEQ_S - 1)); \
            tb[slot][0] = *(const f32x4*)(cosT + pos_ * 32 + 8 * fq); tb[slot][1] = *(const f32x4*)(cosT + pos_ * 32 + 8 * fq + 4); \
            tb[slot][2] = *(const f32x4*)(sinT + pos_ * 32 + 8 * fq); tb[slot][3] = *(const f32x4*)(sinT + pos_ * 32 + 8 * fq + 4); } } while (0)
        QKV_LDT(0, 0);
#pragma unroll
        for (int k = 0; k < 8; ++k) {
            const int ai = k >> 2, m = k & 3;
            const int row = u.pm * BM + ai * HALF + wr * 64 + m * 16 + fr;
            f32x4 v00 = acc[ai][0][m][0], v01 = acc[ai][0][m][1], v10 = acc[ai][1][m][0], v11 = acc[ai][1][m][1];
            if (g) {
                float ss = (dot4(v00) + dot4(v01)) + (dot4(v10) + dot4(v11));
                ss = rows4_sum(ss);
                const float rinv = __builtin_amdgcn_rsqf(ss * (1.0f / 64.0f) + NORM_EPS);
                const f32x4 c0 = tb[0][0], c1 = tb[0][1], s0 = tb[0][2], s1 = tb[0][3];
                const f32x4 y00 = v00 * rinv * gv[0][0], y01 = v01 * rinv * gv[0][1], y10 = v10 * rinv * gv[1][0], y11 = v11 * rinv * gv[1][1];
                v00 = (y00 * c0 - y10 * s0) * sc; v10 = (y10 * c0 + y00 * s0) * sc;
                v01 = (y01 * c1 - y11 * s1) * sc; v11 = (y11 * c1 + y01 * s1) * sc;
            }
            if (k + 1 < 8) { QKV_LDT(k + 1, 0); }
            asm volatile("" ::: "memory");
            bf16_t* rowp = O + (size_t)(pn * 4 + wc) * HS_QKV + (size_t)(row + (row >> 4)) * 64 + fq * 8;
            u32x4 w0, w1;
            w0.x = cvt_pk_bf16(v00[0], v00[1]); w0.y = cvt_pk_bf16(v00[2], v00[3]); w0.z = cvt_pk_bf16(v01[0], v01[1]); w0.w = cvt_pk_bf16(v01[2], v01[3]);
            w1.x = cvt_pk_bf16(v10[0], v10[1]); w1.y = cvt_pk_bf16(v10[2], v10[3]); w1.z = cvt_pk_bf16(v11[0], v11[1]); w1.w = cvt_pk_bf16(v11[2], v11[3]);
            *(u32x4*)(rowp) = w0; *(u32x4*)(rowp + 32) = w1;
        }
#undef QKV_LDT
    }
};

struct EpiOut {
    static constexpr bool PERM = true, AFTER_DRAIN = false;
    const float* xp; const float* xs; bf16_t* xb; float* rowss;
    __device__ __forceinline__ void operator()(const f32x4 (&acc)[2][2][4][2], const Unit& u, int wr, int wc, int fr, int fq) const {
        const int row0 = u.pm * BM;
        const float* xin = row0 < ROWS_P ? xp + (size_t)row0 * 1024 : xs + (size_t)(row0 - ROWS_P) * 1024;
        const int colb = u.pn * BM + wc * 32 + fq * 8;
        f32x4 xa[2][2], xc[2][2];
#define OUT_LD(k) do { _Pragma("unroll") for (int mm_ = 0; mm_ < 2; ++mm_) { const int rl_ = ((k) >> 1) * HALF + wr * 64 + (2 * ((k) & 1) + mm_) * 16 + fr; \
            _Pragma("unroll") for (int bj_ = 0; bj_ < 2; ++bj_) { const int col_ = colb + bj_ * HALF; \
                xa[mm_][bj_] = *(const f32x4*)(xin + (size_t)rl_ * 1024 + col_); xc[mm_][bj_] = *(const f32x4*)(xin + (size_t)rl_ * 1024 + col_ + 4); } } } while (0)
        OUT_LD(0);
#pragma unroll
        for (int k = 0; k < 4; ++k) {
            const int ai = k >> 1, mh = k & 1;
            u32x4 w[2][2]; float ssv[2];
#pragma unroll
            for (int mm = 0; mm < 2; ++mm) {
                const int m = 2 * mh + mm;
                float ss = 0.f;
#pragma unroll
                for (int bj = 0; bj < 2; ++bj) {
                    const f32x4 a = xa[mm][bj] + acc[ai][bj][m][0];
                    const f32x4 b = xc[mm][bj] + acc[ai][bj][m][1];
                    ss += dot4(a) + dot4(b);
                    w[mm][bj].x = cvt_pk_bf16(a[0], a[1]); w[mm][bj].y = cvt_pk_bf16(a[2], a[3]); w[mm][bj].z = cvt_pk_bf16(b[0], b[1]); w[mm][bj].w = cvt_pk_bf16(b[2], b[3]);
                }
                ss = rows4_sum(ss);
                ssv[mm] = ss;
            }
            if (k + 1 < 4) { OUT_LD(k + 1); }
            asm volatile("" ::: "memory");
#pragma unroll
            for (int mm = 0; mm < 2; ++mm) {
                const int m = 2 * mh + mm;
                const int rl = ai * HALF + wr * 64 + m * 16 + fr; const size_t row = (size_t)row0 + rl;
#pragma unroll
                for (int bj = 0; bj < 2; ++bj) *(u32x4*)(xb + row * 1024 + colb + bj * HALF) = w[mm][bj];
                if (fq == 0) atomicAdd(rowss + row, ssv[mm]);
            }
        }
#undef OUT_LD
    }
};

struct EpiGU {
    static constexpr bool PERM = true, AFTER_DRAIN = false;
    bf16_t* H; const float* rowss;
    __device__ __forceinline__ void operator()(const f32x4 (&acc)[2][2][4][2], const Unit& u, int wr, int wc, int fr, int fq) const {
        const int colh = u.pn * HALF + wc * 32 + fq * 8;
        float rsv[2][4];
#pragma unroll
        for (int ai = 0; ai < 2; ++ai)
#pragma unroll
            for (int m = 0; m < 4; ++m) rsv[ai][m] = rowss[(size_t)u.pm * BM + ai * HALF + wr * 64 + m * 16 + fr];
#pragma unroll
        for (int ai = 0; ai < 2; ++ai)
#pragma unroll
            for (int m = 0; m < 4; ++m) rsv[ai][m] = __builtin_amdgcn_rsqf(rsv[ai][m] * (1.0f / 1024.0f) + NORM_EPS);
#pragma unroll
        for (int ai = 0; ai < 2; ++ai)
#pragma unroll
            for (int m = 0; m < 4; ++m) {
                const size_t row = (size_t)u.pm * BM + ai * HALF + wr * 64 + m * 16 + fr;
                const float rstd = rsv[ai][m]; const float k1 = -rstd * 1.4426950408889634f, k2 = rstd * rstd;
                float hv[8];
#pragma unroll
                for (int n = 0; n < 2; ++n)
#pragma unroll
                    for (int i = 0; i < 4; ++i) {
                        const float ga = acc[ai][0][m][n][i], ua = acc[ai][1][m][n][i];
                        const float e = __builtin_amdgcn_exp2f(ga * k1);
                        hv[n * 4 + i] = (ga * ua) * (k2 * __builtin_amdgcn_rcpf(1.0f + e));
                    }
                u32x4 w; w.x = cvt_pk_bf16(hv[0], hv[1]); w.y = cvt_pk_bf16(hv[2], hv[3]); w.z = cvt_pk_bf16(hv[4], hv[5]); w.w = cvt_pk_bf16(hv[6], hv[7]);
                *(u32x4*)(H + row * 2816 + colh) = w;
            }
    }
};

struct EpiDown {
    static constexpr bool PERM = true, AFTER_DRAIN = false;
    float* out; const bf16_t* xb;
    __device__ __forceinline__ void operator()(const f32x4 (&acc)[2][2][4][2], const Unit& u, int wr, int wc, int fr, int fq) const {
        const int colb = u.pn * BM + wc * 32 + fq * 8;
        u32x4 xw[2][2];
#define DN_LD(k) do { _Pragma("unroll") for (int mm_ = 0; mm_ < 2; ++mm_) { const size_t row_ = (size_t)u.pm * BM + ((k) >> 1) * HALF + wr * 64 + (2 * ((k) & 1) + mm_) * 16 + fr; \
            _Pragma("unroll") for (int bj_ = 0; bj_ < 2; ++bj_) xw[mm_][bj_] = *(const u32x4*)(xb + row_ * 1024 + colb + bj_ * HALF); } } while (0)
        DN_LD(0);
#pragma unroll
        for (int k = 0; k < 4; ++k) {
            const int ai = k >> 1, mh = k & 1;
            f32x4 ra[2][2], rb[2][2];
#pragma unroll
            for (int mm = 0; mm < 2; ++mm) {
                const int m = 2 * mh + mm;
#pragma unroll
                for (int bj = 0; bj < 2; ++bj) {
                    const u32x4 w = xw[mm][bj];
                    f32x4 xa, xc;
                    xa[0] = __builtin_bit_cast(float, w.x << 16); xa[1] = __builtin_bit_cast(float, w.x & 0xffff0000u); xa[2] = __builtin_bit_cast(float, w.y << 16); xa[3] = __builtin_bit_cast(float, w.y & 0xffff0000u);
                    xc[0] = __builtin_bit_cast(float, w.z << 16); xc[1] = __builtin_bit_cast(float, w.z & 0xffff0000u); xc[2] = __builtin_bit_cast(float, w.w << 16); xc[3] = __builtin_bit_cast(float, w.w & 0xffff0000u);
                    ra[mm][bj] = xa + acc[ai][bj][m][0]; rb[mm][bj] = xc + acc[ai][bj][m][1];
                }
            }
            if (k + 1 < 4) { DN_LD(k + 1); }
            asm volatile("" ::: "memory");
#pragma unroll
            for (int mm = 0; mm < 2; ++mm) {
                const size_t row = (size_t)u.pm * BM + ai * HALF + wr * 64 + (2 * mh + mm) * 16 + fr;
#pragma unroll
                for (int bj = 0; bj < 2; ++bj) { float* p = out + row * 1024 + colb + bj * HALF; *(f32x4*)p = ra[mm][bj]; *(f32x4*)(p + 4) = rb[mm][bj]; }
            }
        }
#undef DN_LD
    }
};
}

#ifndef PG8_SP2
#define PG8_SP2 true
#endif
#ifndef PG8_ALIGN
#define PG8_ALIGN true
#endif

constexpr int NWAVES = 8;
constexpr int D = 1024, M = 98304, NIN = 2304, DFF = 2816, NGU = 2 * DFF;
constexpr int ROWS_P = pg8::ROWS_P, SEQ_P = pg8::SEQ_P, SEQ_S = pg8::SEQ_S;
constexpr size_t MiB = 1u << 20;
constexpr size_t WS_ROWSS = 0;
constexpr size_t WS_BAR = 512 * 1024, WS_BAR_BYTES = 16384;
constexpr size_t WS_COS = 1 * MiB, WS_SIN = 3 * MiB;
constexpr size_t WS_WIN = 8 * MiB;
constexpr size_t WS_WOUT = 13 * MiB;
constexpr size_t WS_WGU = 15 * MiB;
constexpr size_t WS_WDN = 26 * MiB;
constexpr size_t WS_XN = 32 * MiB;
constexpr size_t WS_QKV = 232 * MiB;
constexpr size_t WS_H = WS_QKV;
constexpr size_t WS_XB = 768 * MiB;
constexpr size_t WS_END = 960 * MiB;
static_assert(WS_XN + (size_t)M * D * 2 <= WS_QKV && WS_H + (size_t)M * DFF * 2 <= WS_XB && WS_XB + (size_t)M * D * 2 <= WS_END, "d_ws map");

constexpr int RING_BYTES = 131072, LDS_BYTES = 147456;

#define GAS __attribute__((address_space(1)))
#define LAS __attribute__((address_space(3)))
typedef unsigned short bf16;
typedef unsigned v4u __attribute__((ext_vector_type(4)));
typedef float f32x4 __attribute__((ext_vector_type(4)));
__device__ __forceinline__ unsigned f2bf(float f) { unsigned u = __builtin_bit_cast(unsigned, f); return (u + 0x7fffu + ((u >> 16) & 1u)) >> 16; }
__device__ __forceinline__ unsigned pk2(float lo, float hi) { return pg8::cvt_pk_bf16(lo, hi); }
__device__ __forceinline__ float wave_sum(float v) {
#pragma unroll
    for (int o = 1; o < 64; o <<= 1) v += __shfl_xor(v, o);
    return v;
}

__device__ __forceinline__ void p0_transpose_item(const float* W, int K, int N, bf16* WT, int dst_row0, const float* gain, LAS float* scr, int kb, int nb, int lane) {
    const int k0 = 64 * kb, n0 = 32 * nb;
#pragma unroll 8
    for (int i = 0; i < 32; ++i) { const int kk = 2 * i + (lane >> 5); float v = W[(size_t)(k0 + kk) * N + n0 + (lane & 31)]; if (gain) v *= gain[k0 + kk]; scr[kk * 33 + (lane & 31)] = v; }
    asm volatile("s_waitcnt lgkmcnt(0)" ::: "memory");
    const int c = lane & 7;
#pragma unroll
    for (int j = 0; j < 4; ++j) { const int n = (lane >> 3) + 8 * j; const LAS float* s = scr + (8 * c) * 33 + n;
        v4u o; o.x = pk2(s[0 * 33], s[1 * 33]); o.y = pk2(s[2 * 33], s[3 * 33]); o.z = pk2(s[4 * 33], s[5 * 33]); o.w = pk2(s[6 * 33], s[7 * 33]);
        *(v4u*)(WT + (size_t)(dst_row0 + n) * K + k0 + 8 * c) = o; }
    asm volatile("s_waitcnt lgkmcnt(0)" ::: "memory");
}

__device__ const float ROPE_INV[32] = {
    1.000000000e+00f, 7.498942614e-01f, 5.623413324e-01f, 4.216965139e-01f, 3.162277639e-01f, 2.371373773e-01f, 1.778279394e-01f, 1.333521307e-01f,
    1.000000015e-01f, 7.498941571e-02f, 5.623413250e-02f, 4.216965288e-02f, 3.162277490e-02f, 2.371373773e-02f, 1.778279431e-02f, 1.333521493e-02f,
    9.999999776e-03f, 7.498941850e-03f, 5.623413250e-03f, 4.216964822e-03f, 3.162277630e-03f, 2.371373586e-03f, 1.778279431e-03f, 1.333521446e-03f,
    1.000000047e-03f, 7.498942432e-04f, 5.623413017e-04f, 4.216965172e-04f, 3.162277571e-04f, 2.371373703e-04f, 1.778279402e-04f, 1.333521504e-04f};

__device__ __forceinline__ void rope_entry(int pos, int j, float& co, float& si) {
    const float ang = (float)pos * ROPE_INV[j];
    const double a = (double)ang;
    const double k = __builtin_rint(a * 0.15915494309189535);
    double r = __builtin_fma(-k, 6.283185307179586, a); r = __builtin_fma(-k, 2.4492935982947064e-16, r);
    const double q = __builtin_rint(r * 0.6366197723675814);
    double x = __builtin_fma(-q, 1.5707963267948966, r); x = __builtin_fma(-q, 6.123233995736766e-17, x);
    const double x2 = x * x;
    const double s = x * (1.0 + x2 * (-1.0 / 6 + x2 * (1.0 / 120 + x2 * (-1.0 / 5040 + x2 * (1.0 / 362880 + x2 * (-1.0 / 39916800 + x2 * (1.0 / 6227020800.0)))))));
    const double c = 1.0 + x2 * (-0.5 + x2 * (1.0 / 24 + x2 * (-1.0 / 720 + x2 * (1.0 / 40320 + x2 * (-1.0 / 3628800 + x2 * (1.0 / 479001600 + x2 * (-1.0 / 87178291200.0)))))));
    const int qi = ((int)q) & 3;
    const double sn = (qi == 0) ? s : (qi == 1) ? c : (qi == 2) ? -s : -c;
    const double cs = (qi == 0) ? c : (qi == 1) ? -s : (qi == 2) ? -c : s;
    co = (float)cs; si = (float)sn;
}

namespace att {
typedef short bf16x8 __attribute__((ext_vector_type(8)));
typedef short s16x4 __attribute__((ext_vector_type(4)));
typedef float f32x16 __attribute__((ext_vector_type(16)));
typedef unsigned u32x4 __attribute__((ext_vector_type(4)));
typedef unsigned u32x2 __attribute__((ext_vector_type(2)));
typedef float f32x2_t __attribute__((ext_vector_type(2))); typedef __bf16 bf16x2_t __attribute__((ext_vector_type(2)));
typedef short v4i16_t __attribute__((ext_vector_type(4)));
constexpr int QP = 64;
constexpr size_t HS = (size_t)(M + M / 16) * 64;
__device__ __forceinline__ size_t rofs(int r) { return (size_t)(r + (r >> 4)) * 64; }
constexpr int VS = 144;
constexpr int VIMG_BYTES = 32 * VS;
constexpr int LDS_O1 = NWAVES * 2 * VIMG_BYTES, O1S = 136, LDS_L1 = LDS_O1 + 512 * O1S, LDS_ATT_END = LDS_L1 + 512 * 4;
static_assert(LDS_ATT_END <= LDS_BYTES, "attention LDS map");
constexpr int N_UNITS_A = (M / 512) * 8, N_ITEMS_B = M / 32 * 8;
#ifndef ATT_REP_A
#define ATT_REP_A 1
#endif
#ifndef ATT_REP_B
#define ATT_REP_B 1
#endif
__device__ __forceinline__ unsigned cvtpk(float lo, float hi) { f32x2_t v = {lo, hi}; bf16x2_t b = __builtin_convertvector(v, bf16x2_t); return __builtin_bit_cast(unsigned, b); }
__device__ __forceinline__ s16x4 vtr(const LAS char* p) { return __builtin_bit_cast(s16x4, __builtin_amdgcn_ds_read_tr16_b64_v4i16((LAS v4i16_t*)p)); }
__device__ __forceinline__ float bflo(unsigned w) { return __builtin_bit_cast(float, w << 16); }
__device__ __forceinline__ float bfhi(unsigned w) { return __builtin_bit_cast(float, w & 0xffff0000u); }

__device__ __forceinline__ f32x16 qk(const bf16x8 (&kf)[4], const bf16x8 (&qf)[4]) {
    f32x16 sc;
#pragma unroll
    for (int r = 0; r < 16; ++r) sc[r] = 0.f;
#pragma unroll
    for (int s = 0; s < 4; ++s) sc = __builtin_amdgcn_mfma_f32_32x32x16_bf16(kf[s], qf[s], sc, 0, 0, 0);
    return sc;
}

__device__ __forceinline__ void tile_finish(f32x16& o0, f32x16& o1, float& lsum, f32x16 sc, const bf16x8 (&vf)[4], bool safe, int tb, int lb, int L) {
    if (!safe) {
#pragma unroll
        for (int r = 0; r < 16; ++r) {
            const int cr = (r & 3) + 8 * (r >> 2);
            const bool ok = ((unsigned)(tb + cr) <= 128u) && ((unsigned)(lb + cr) < (unsigned)L);
            sc[r] = ok ? sc[r] : -INFINITY;
        }
    }
    float p[16];
#pragma unroll
    for (int r = 0; r < 16; ++r) { p[r] = __builtin_amdgcn_exp2f(sc[r]); lsum += p[r]; }
    u32x4 pw0, pw1;
    pw0.x = cvtpk(p[0], p[1]); pw0.y = cvtpk(p[2], p[3]); pw0.z = cvtpk(p[4], p[5]); pw0.w = cvtpk(p[6], p[7]);
    pw1.x = cvtpk(p[8], p[9]); pw1.y = cvtpk(p[10], p[11]); pw1.z = cvtpk(p[12], p[13]); pw1.w = cvtpk(p[14], p[15]);
    const bf16x8 pf0 = __builtin_bit_cast(bf16x8, pw0), pf1 = __builtin_bit_cast(bf16x8, pw1);
    o0 = __builtin_amdgcn_mfma_f32_32x32x16_bf16(vf[0], pf0, o0, 0, 0, 0);
    o1 = __builtin_amdgcn_mfma_f32_32x32x16_bf16(vf[1], pf0, o1, 0, 0, 0);
    o0 = __builtin_amdgcn_mfma_f32_32x32x16_bf16(vf[2], pf1, o0, 0, 0, 0);
    o1 = __builtin_amdgcn_mfma_f32_32x32x16_bf16(vf[3], pf1, o1, 0, 0, 0);
}
__device__ __forceinline__ void tile_block(f32x16& o0, f32x16& o1, float& lsum, const bf16x8 (&qf)[4], const bf16x8 (&kf)[4], const bf16x8 (&vf)[4], bool safe, int tb, int lb, int L) {
    tile_finish(o0, o1, lsum, qk(kf, qf), vf, safe, tb, lb, L);
}
__device__ __forceinline__ void load_kv2(u32x4 (&kn)[4], u32x4 (&vn)[4], const bf16* kbase, const bf16* vbase, int l0, int L, int rho, int shift, int lane) {
#pragma unroll
    for (int c = 0; c < 4; ++c) { int lv = l0 + 8 * c + (lane >> 3); lv = lv < 0 ? 0 : (lv > L - 1 ? L - 1 : lv);
        const size_t ro = rofs(rho + (lv << shift));
        kn[c] = *(const u32x4*)(kbase + ro); vn[c] = *(const u32x4*)(vbase + ro); }
}
__device__ __forceinline__ void pre_kv(u32x4 (&kn)[4], u32x4 (&vn)[4], const bf16* kbase, const bf16* vbase, int lstart, int L, int rho, int shift, int lane) {
    const int b_lo = (lstart < -31) ? ((-lstart) >> 5) : 0;
    load_kv2(kn, vn, kbase, vbase, lstart + 32 * b_lo, L, rho, shift, lane);
}
template <bool DUAL>
__device__ __forceinline__ void run_branch2(f32x16& oA0, f32x16& oA1, float& lsA, const bf16x8 (&qfA)[4], f32x16& oB0, f32x16& oB1, float& lsB, const bf16x8 (&qfB)[4],
                                            const bf16* kbase, const bf16* vbase, int rho, int shift, int L, int lstart, u32x4 (&kn)[4], u32x4 (&vn)[4], LAS char* vimg, int lane) {
    const int qi = lane & 31, hi = lane >> 5;
    const int tqA = qi - 4 * hi, tqB = tqA + 32;
    const int b_lo = (lstart < -31) ? ((-lstart) >> 5) : 0;
    int b_hi = (L - lstart + 31) >> 5; if (b_hi > (DUAL ? 6 : 5)) b_hi = DUAL ? 6 : 5;
    const LAS char* krd = vimg + qi * VS + hi * 16;
    const LAS char* vrd = vimg + VIMG_BYTES + (4 * hi + ((lane & 15) >> 2)) * VS + ((lane >> 4) & 1) * 32 + (lane & 3) * 8;
    LAS char* kwr = vimg + (lane >> 3) * VS + (lane & 7) * 16;
#pragma unroll 1
    for (int b = b_lo; b < b_hi; ++b) {
#pragma unroll
        for (int c = 0; c < 4; ++c) { *(LAS u32x4*)(kwr + c * 8 * VS) = kn[c]; *(LAS u32x4*)(kwr + VIMG_BYTES + c * 8 * VS) = vn[c]; }
        if (b + 1 < b_hi) load_kv2(kn, vn, kbase, vbase, lstart + 32 * (b + 1), L, rho, shift, lane);
        bf16x8 kf[4], vf[4];
#pragma unroll
        for (int s = 0; s < 4; ++s) kf[s] = *(const LAS bf16x8*)(krd + 32 * s);
#define ATT_VF(t, d0) __builtin_shufflevector(vtr(vrd + (16 * (t)) * VS + 64 * (d0)), vtr(vrd + (16 * (t) + 8) * VS + 64 * (d0)), 0, 1, 2, 3, 4, 5, 6, 7)
        vf[0] = ATT_VF(0, 0); vf[1] = ATT_VF(0, 1); vf[2] = ATT_VF(1, 0); vf[3] = ATT_VF(1, 1);
#undef ATT_VF
        const int l0 = lstart + 32 * b;
        const bool inr = (l0 >= 0) && (l0 + 31 < L);
        if (b <= 4) tile_block(oA0, oA1, lsA, qfA, kf, vf, inr && b >= 1 && b <= 3, 32 * b - tqA, l0 + 4 * hi, L);
        if (DUAL && b >= 1) tile_block(oB0, oB1, lsB, qfB, kf, vf, inr && b >= 2 && b <= 4, 32 * b - tqB, l0 + 4 * hi, L);
    }
}

__device__ __forceinline__ void run_branch1(f32x16& o0, f32x16& o1, float& lsum, const bf16x8 (&qf)[4], const bf16* kbase, const bf16* vbase, int rho, int shift, int L, int lstart,
                                            u32x4 (&kn)[4], u32x4 (&vn)[4], LAS char* vimg, int lane) {
    const int qi = lane & 31, hi = lane >> 5;
    const int tq = qi - 4 * hi;
    const int b_lo = (lstart < -31) ? ((-lstart) >> 5) : 0;
    int b_hi = (L - lstart + 31) >> 5; if (b_hi > 5) b_hi = 5;
    const LAS char* krd = vimg + qi * VS + hi * 16;
    const LAS char* vrd = vimg + VIMG_BYTES + (4 * hi + ((lane & 15) >> 2)) * VS + ((lane >> 4) & 1) * 32 + (lane & 3) * 8;
    LAS char* kwr = vimg + (lane >> 3) * VS + (lane & 7) * 16;
#define ATT_VF(t, d0) __builtin_shufflevector(vtr(vrd + (16 * (t)) * VS + 64 * (d0)), vtr(vrd + (16 * (t) + 8) * VS + 64 * (d0)), 0, 1, 2, 3, 4, 5, 6, 7)
#define R1_STAGE_QK(bn, scX, vfX) do { \
        _Pragma("unroll") for (int c = 0; c < 4; ++c) { *(LAS u32x4*)(kwr + c * 8 * VS) = kn[c]; *(LAS u32x4*)(kwr + VIMG_BYTES + c * 8 * VS) = vn[c]; } \
        if ((bn) + 1 < b_hi) load_kv2(kn, vn, kbase, vbase, lstart + 32 * ((bn) + 1), L, rho, shift, lane); \
        bf16x8 kf_[4]; \
        _Pragma("unroll") for (int s = 0; s < 4; ++s) kf_[s] = *(const LAS bf16x8*)(krd + 32 * s); \
        scX = qk(kf_, qf); \
        vfX[0] = ATT_VF(0, 0); vfX[1] = ATT_VF(0, 1); vfX[2] = ATT_VF(1, 0); vfX[3] = ATT_VF(1, 1); } while (0)
#define R1_FIN(bb, scX, vfX) do { const int l0_ = lstart + 32 * (bb); \
        tile_finish(o0, o1, lsum, scX, vfX, (l0_ >= 0) && (l0_ + 31 < L) && (bb) >= 1 && (bb) <= 3, 32 * (bb) - tq, l0_ + 4 * hi, L); } while (0)
    f32x16 scA, scB; bf16x8 vfA[4], vfB[4];
    int b = b_lo;
    R1_STAGE_QK(b, scA, vfA);
#pragma unroll 1
    for (; b + 1 < b_hi; b += 2) {
        R1_STAGE_QK(b + 1, scB, vfB);
        R1_FIN(b, scA, vfA);
        if (b + 2 < b_hi) R1_STAGE_QK(b + 2, scA, vfA);
        R1_FIN(b + 1, scB, vfB);
    }
    if (b < b_hi) R1_FIN(b, scA, vfA);
#undef R1_STAGE_QK
#undef R1_FIN
#undef ATT_VF
}

__device__ __forceinline__ void store_out(const f32x16& o0, const f32x16& o1, float inv, bf16* out0, size_t rstride, LAS char* stg, int lane) {
    const int qi = lane & 31, hi = lane >> 5;
    LAS char* w = stg + qi * VS + 8 * hi;
#pragma unroll
    for (int c = 0; c < 4; ++c) {
        u32x2 w0, w1;
        w0.x = cvtpk(o0[4 * c] * inv, o0[4 * c + 1] * inv); w0.y = cvtpk(o0[4 * c + 2] * inv, o0[4 * c + 3] * inv);
        w1.x = cvtpk(o1[4 * c] * inv, o1[4 * c + 1] * inv); w1.y = cvtpk(o1[4 * c + 2] * inv, o1[4 * c + 3] * inv);
        *(LAS u32x2*)(w + 16 * c) = w0; *(LAS u32x2*)(w + 64 + 16 * c) = w1;
    }
#pragma unroll
    for (int j = 0; j < 4; ++j) {
        const int row = 8 * j + (lane >> 3), ch = lane & 7;
        const u32x4 v = *(const LAS u32x4*)(stg + row * VS + ch * 16);
        *(u32x4*)(out0 + (size_t)row * rstride + ch * 8) = v;
    }
}

__device__ __forceinline__ void attention_phase(const bf16* QKV, bf16* AO, const float* sink, LAS unsigned char* lds, int vcu, int G, int wave, int lane) {
    const int qi = lane & 31, hi = lane >> 5;
    LAS char* vimg = (LAS char*)lds + wave * (2 * VIMG_BYTES);
    LAS char* O1 = (LAS char*)lds + LDS_O1; LAS float* L1 = (LAS float*)((LAS char*)lds + LDS_L1);
    {
    u32x4 kn[4], vn[4]; bf16x8 qA[4], qB[4];
#define QLD(dst, hh, row) do { const bf16* qp_ = QKV + (size_t)(hh) * HS + rofs((int)(row)) + 8 * hi; _Pragma("unroll") for (int s_ = 0; s_ < 4; ++s_) dst[s_] = *(const bf16x8*)(qp_ + 16 * s_); } while (0)
#define UNIT_PARAMS(uu, h, S, seq_row, pc, kb_, vb_) const int h = (uu) / (M / 512); const int rowc_##h = ((uu) % (M / 512)) * 512; const int S = rowc_##h < ROWS_P ? SEQ_P : SEQ_S; \
        const int seq_row = rowc_##h & ~(S - 1), pc = rowc_##h - seq_row; const bf16* kb_ = QKV + rofs(seq_row) + (8 + h) * HS + (lane & 7) * 8; const bf16* vb_ = QKV + rofs(seq_row) + (16 + h) * HS + (lane & 7) * 8
    if (vcu < N_UNITS_A) { UNIT_PARAMS(vcu, h0, S0, sr0, pc0, kb0, vb0); const int P0 = pc0 + 64 * wave;
        QLD(qA, h0, sr0 + P0 + qi); QLD(qB, h0, sr0 + P0 + 32 + qi); pre_kv(kn, vn, kb0, vb0, P0 - 64, S0, 0, 0, lane); }
    for (int u = vcu; u < N_UNITS_A; u += G) {
        UNIT_PARAMS(u, h, S, seq_row, pc, kb_, vb_);
        {
            const int P0 = pc + 64 * wave;
            f32x16 oA0, oA1, oB0, oB1; float lsA = 0.f, lsB = 0.f;
#pragma unroll
            for (int r = 0; r < 16; ++r) { oA0[r] = 0.f; oA1[r] = 0.f; oB0[r] = 0.f; oB1[r] = 0.f; }
            run_branch2<true>(oA0, oA1, lsA, qA, oB0, oB1, lsB, qB, kb_, vb_, 0, 0, S, P0 - 64, kn, vn, vimg, lane);
            { const int P0b = pc + (wave & 3) + 256 * (wave >> 2);
              QLD(qA, h, seq_row + P0b + 4 * qi); QLD(qB, h, seq_row + P0b + 128 + 4 * qi); pre_kv(kn, vn, kb_, vb_, (P0b >> 2) - 64, S >> 2, P0b & 3, 2, lane); }
            lsA += __shfl_xor(lsA, 32); lsB += __shfl_xor(lsB, 32);
            LAS char* orowA = O1 + (64 * wave + qi) * O1S + 8 * hi; LAS char* orowB = orowA + 32 * O1S;
#pragma unroll
            for (int c = 0; c < 4; ++c) {
                u32x2 w0, w1;
                w0.x = cvtpk(oA0[4 * c], oA0[4 * c + 1]); w0.y = cvtpk(oA0[4 * c + 2], oA0[4 * c + 3]);
                w1.x = cvtpk(oA1[4 * c], oA1[4 * c + 1]); w1.y = cvtpk(oA1[4 * c + 2], oA1[4 * c + 3]);
                *(LAS u32x2*)(orowA + 16 * c) = w0; *(LAS u32x2*)(orowA + 64 + 16 * c) = w1;
                w0.x = cvtpk(oB0[4 * c], oB0[4 * c + 1]); w0.y = cvtpk(oB0[4 * c + 2], oB0[4 * c + 3]);
                w1.x = cvtpk(oB1[4 * c], oB1[4 * c + 1]); w1.y = cvtpk(oB1[4 * c + 2], oB1[4 * c + 3]);
                *(LAS u32x2*)(orowB + 16 * c) = w0; *(LAS u32x2*)(orowB + 64 + 16 * c) = w1;
            }
            if (hi == 0) { L1[64 * wave + qi] = lsA; L1[64 * wave + 32 + qi] = lsB; }
        }
        __syncthreads();
        {
            const int c = wave & 3, tp = wave >> 2, P0 = pc + c + 256 * tp;
            f32x16 oA0, oA1, oB0, oB1; float lsA = 0.f, lsB = 0.f;
#pragma unroll
            for (int r = 0; r < 16; ++r) { oA0[r] = 0.f; oA1[r] = 0.f; oB0[r] = 0.f; oB1[r] = 0.f; }
            run_branch2<true>(oA0, oA1, lsA, qA, oB0, oB1, lsB, qB, kb_, vb_, P0 & 3, 2, S >> 2, (P0 >> 2) - 64, kn, vn, vimg, lane);
            { const int P0c = pc + wave;
              QLD(qA, h, seq_row + P0c + 16 * qi); pre_kv(kn, vn, kb_, vb_, (P0c >> 4) - 64, S >> 4, P0c & 15, 4, lane); }
            lsA += __shfl_xor(lsA, 32); lsB += __shfl_xor(lsB, 32);
            const int lrowA = P0 - pc + 4 * qi, lrowB = lrowA + 128;
            lsA += L1[lrowA]; lsB += L1[lrowB];
            LAS char* prowA = O1 + lrowA * O1S + 8 * hi; LAS char* prowB = prowA + 128 * O1S;
#pragma unroll
            for (int cc = 0; cc < 4; ++cc) {
                u32x2 r0 = *(const LAS u32x2*)(prowA + 16 * cc), r1 = *(const LAS u32x2*)(prowA + 64 + 16 * cc);
                u32x2 w0, w1;
                w0.x = cvtpk(oA0[4 * cc] + bflo(r0.x), oA0[4 * cc + 1] + bfhi(r0.x)); w0.y = cvtpk(oA0[4 * cc + 2] + bflo(r0.y), oA0[4 * cc + 3] + bfhi(r0.y));
                w1.x = cvtpk(oA1[4 * cc] + bflo(r1.x), oA1[4 * cc + 1] + bfhi(r1.x)); w1.y = cvtpk(oA1[4 * cc + 2] + bflo(r1.y), oA1[4 * cc + 3] + bfhi(r1.y));
                *(LAS u32x2*)(prowA + 16 * cc) = w0; *(LAS u32x2*)(prowA + 64 + 16 * cc) = w1;
                r0 = *(const LAS u32x2*)(prowB + 16 * cc); r1 = *(const LAS u32x2*)(prowB + 64 + 16 * cc);
                w0.x = cvtpk(oB0[4 * cc] + bflo(r0.x), oB0[4 * cc + 1] + bfhi(r0.x)); w0.y = cvtpk(oB0[4 * cc + 2] + bflo(r0.y), oB0[4 * cc + 3] + bfhi(r0.y));
                w1.x = cvtpk(oB1[4 * cc] + bflo(r1.x), oB1[4 * cc + 1] + bfhi(r1.x)); w1.y = cvtpk(oB1[4 * cc + 2] + bflo(r1.y), oB1[4 * cc + 3] + bfhi(r1.y));
                *(LAS u32x2*)(prowB + 16 * cc) = w0; *(LAS u32x2*)(prowB + 64 + 16 * cc) = w1;
            }
            if (hi == 0) { L1[lrowA] = lsA; L1[lrowB] = lsB; }
        }
        __syncthreads();
#define FINALIZE_ITEM(r_, P0_) do { lsum += __shfl_xor(lsum, 32); const int lrow = (r_) + 16 * qi; lsum += L1[lrow]; const LAS char* prow = O1 + lrow * O1S + 8 * hi; \
            _Pragma("unroll") for (int c = 0; c < 4; ++c) { const u32x2 w0 = *(const LAS u32x2*)(prow + 16 * c), w1 = *(const LAS u32x2*)(prow + 64 + 16 * c); \
                o0[4 * c] += bflo(w0.x); o0[4 * c + 1] += bfhi(w0.x); o0[4 * c + 2] += bflo(w0.y); o0[4 * c + 3] += bfhi(w0.y); \
                o1[4 * c] += bflo(w1.x); o1[4 * c + 1] += bfhi(w1.x); o1[4 * c + 2] += bflo(w1.y); o1[4 * c + 3] += bfhi(w1.y); } \
            store_out(o0, o1, 1.0f / lsum, AO + (size_t)(seq_row + (P0_)) * 1024 + h * 64, (size_t)16 * 1024, vimg, lane); } while (0)
        {
            const int P0 = pc + wave;
            f32x16 o0, o1; float lsum = 0.f;
#pragma unroll
            for (int rr = 0; rr < 16; ++rr) { o0[rr] = 0.f; o1[rr] = 0.f; }
            run_branch1(o0, o1, lsum, qA, kb_, vb_, P0 & 15, 4, S >> 4, (P0 >> 4) - 64, kn, vn, vimg, lane);
            { const int P0d = pc + wave + 8;
              QLD(qB, h, seq_row + P0d + 16 * qi); pre_kv(kn, vn, kb_, vb_, (P0d >> 4) - 64, S >> 4, P0d & 15, 4, lane); }
            FINALIZE_ITEM(wave, P0);
        }
        {
            const int P0 = pc + wave + 8;
            f32x16 o0, o1; float lsum = 0.f;
#pragma unroll
            for (int rr = 0; rr < 16; ++rr) { o0[rr] = 0.f; o1[rr] = 0.f; }
            run_branch1(o0, o1, lsum, qB, kb_, vb_, P0 & 15, 4, S >> 4, (P0 >> 4) - 64, kn, vn, vimg, lane);
            if (u + G < N_UNITS_A) { UNIT_PARAMS(u + G, hn, Sn, srn, pcn, kbn, vbn); const int P0n = pcn + 64 * wave;
                QLD(qA, hn, srn + P0n + qi); QLD(qB, hn, srn + P0n + 32 + qi); pre_kv(kn, vn, kbn, vbn, P0n - 64, Sn, 0, 0, lane); }
            FINALIZE_ITEM(wave + 8, P0);
        }
#undef FINALIZE_ITEM
        __syncthreads();
    }
#undef QLD
#undef UNIT_PARAMS
    }
    {
        constexpr int KVB = 2 * VIMG_BYTES;
        constexpr int N_UNITS_B = 2 * (M / 64), UPW = 12;
        static_assert(10 * KVB + NWAVES * VIMG_BYTES <= LDS_BYTES, "mixer B LDS map");
        const int tid = wave * 64 + lane, chunk = tid & 7, r0 = tid >> 3;
        LAS char* kvw = (LAS char*)lds + (r0 >> 5) * KVB + (r0 & 31) * VS + chunk * 16;
        const int tile = wave >> 2, hq = wave & 3;
        const LAS char* krd = (const LAS char*)lds + (lane & 31) * VS + hi * 16;
        const LAS char* vrd = (const LAS char*)lds + VIMG_BYTES + (4 * hi + ((lane & 15) >> 2)) * VS + ((lane >> 4) & 1) * 32 + (lane & 3) * 8;
        u32x4 rk[5], rv[5]; bf16x8 qn[4];
        auto unit_ptrs = [&](int u, int& g, int& p0, int& S, int& seq_row) { g = u / (M / 64); const int row0 = (u % (M / 64)) * 64; S = row0 < ROWS_P ? SEQ_P : SEQ_S; seq_row = row0 & ~(S - 1); p0 = row0 - seq_row; };
        const int u_begin = (G == 256) ? vcu * UPW : vcu, u_step = (G == 256) ? 1 : G, u_count = (G == 256) ? UPW : (N_UNITS_B - vcu + G - 1) / G;
#define MB_LOAD(u) do { int g_, p0_, S_, sr_; unit_ptrs((u), g_, p0_, S_, sr_); const bf16* kb2 = QKV + (32 + g_) * HS + rofs(sr_) + chunk * 8; \
        { const bf16* qp_ = QKV + (24 + 4 * g_ + hq) * HS + rofs(sr_ + p0_ + 32 * tile + qi) + 8 * hi; _Pragma("unroll") for (int s = 0; s < 4; ++s) qn[s] = *(const bf16x8*)(qp_ + 16 * s); } \
        _Pragma("unroll") for (int j = 0; j < 5; ++j) { int l = p0_ - 128 + r0 + 64 * j; l = l < 0 ? 0 : (l > S_ - 1 ? S_ - 1 : l); \
            rk[j] = *(const u32x4*)(kb2 + rofs(l)); rv[j] = *(const u32x4*)(kb2 + 2 * HS + rofs(l)); } } while (0)
        for (int rep = 0; rep < ATT_REP_B; ++rep) {
        if (u_count > 0) MB_LOAD(u_begin);
#pragma unroll 1
        for (int ui = 0; ui < u_count; ++ui) {
            const int u = u_begin + ui * u_step;
            int g, p0, S, seq_row; unit_ptrs(u, g, p0, S, seq_row);
#pragma unroll
            for (int j = 0; j < 5; ++j) { *(LAS u32x4*)(kvw + 2 * j * KVB) = rk[j]; *(LAS u32x4*)(kvw + 2 * j * KVB + VIMG_BYTES) = rv[j]; }
            __syncthreads();
            bf16x8 qf[4];
#pragma unroll
            for (int s = 0; s < 4; ++s) qf[s] = qn[s];
            if (ui + 1 < u_count) MB_LOAD(u + u_step);
            const int hb = 4 * g + hq, P0 = p0 + 32 * tile;
            const size_t qrow = (size_t)(seq_row + P0 + qi);
            f32x16 o0, o1; float lsum = (hi == 0) ? __builtin_amdgcn_exp2f(sink[hb] * 1.4426950408889634f) : 0.f;
#pragma unroll
            for (int r = 0; r < 16; ++r) { o0[r] = 0.f; o1[r] = 0.f; }
            const int lstart = P0 - 128;
            const int b_lo = (lstart < -31) ? ((-lstart) >> 5) : 0;
            int b_hi = (S - lstart + 31) >> 5; if (b_hi > 9) b_hi = 9;
            const int tq = qi - 4 * hi;
#define MB_QK(b, scv, vfv) do { \
                const LAS char* kp = krd + ((b) + tile) * KVB; \
                bf16x8 kf[4]; \
                _Pragma("unroll") for (int s = 0; s < 4; ++s) kf[s] = *(const LAS bf16x8*)(kp + 32 * s); \
                scv = qk(kf, qf); \
                const LAS char* vr = vrd + ((b) + tile) * KVB; \
                vfv[0] = ATT_VF(0, 0); vfv[1] = ATT_VF(0, 1); vfv[2] = ATT_VF(1, 0); vfv[3] = ATT_VF(1, 1); } while (0)
#define MB_FIN(b, scv, vfv) do { \
                const int l0 = lstart + 32 * (b); \
                const bool safe_ = ((b) >= 1) && ((b) <= 7) && (l0 >= 0) && (l0 + 31 < S); \
                if (!safe_) { \
                    const int tb = 32 * (b) - tq, lb = l0 + 4 * hi; \
                    _Pragma("unroll") for (int r = 0; r < 16; ++r) { \
                        const int cr = (r & 3) + 8 * (r >> 2); \
                        const bool ok = ((unsigned)(tb + cr) <= 256u) && ((unsigned)(lb + cr) < (unsigned)S); \
                        scv[r] = ok ? scv[r] : -INFINITY; } } \
                float p[16]; \
                _Pragma("unroll") for (int r = 0; r < 16; ++r) { p[r] = __builtin_amdgcn_exp2f(scv[r]); lsum += p[r]; } \
                u32x4 pw0, pw1; \
                pw0.x = cvtpk(p[0], p[1]); pw0.y = cvtpk(p[2], p[3]); pw0.z = cvtpk(p[4], p[5]); pw0.w = cvtpk(p[6], p[7]); \
                pw1.x = cvtpk(p[8], p[9]); pw1.y = cvtpk(p[10], p[11]); pw1.z = cvtpk(p[12], p[13]); pw1.w = cvtpk(p[14], p[15]); \
                const bf16x8 pf0 = __builtin_bit_cast(bf16x8, pw0), pf1 = __builtin_bit_cast(bf16x8, pw1); \
                o0 = __builtin_amdgcn_mfma_f32_32x32x16_bf16(vfv[0], pf0, o0, 0, 0, 0); \
                o1 = __builtin_amdgcn_mfma_f32_32x32x16_bf16(vfv[1], pf0, o1, 0, 0, 0); \
                o0 = __builtin_amdgcn_mfma_f32_32x32x16_bf16(vfv[2], pf1, o0, 0, 0, 0); \
                o1 = __builtin_amdgcn_mfma_f32_32x32x16_bf16(vfv[3], pf1, o1, 0, 0, 0); } while (0)
#define ATT_VF(t, d0) __builtin_shufflevector(vtr(vr + (16 * (t)) * VS + 64 * (d0)), vtr(vr + (16 * (t) + 8) * VS + 64 * (d0)), 0, 1, 2, 3, 4, 5, 6, 7)
            {
                f32x16 scA, scB; bf16x8 vfA[4], vfB[4];
                int b = b_lo;
                MB_QK(b, scA, vfA);
#pragma unroll 1
                for (; b + 1 < b_hi; b += 2) {
                    MB_QK(b + 1, scB, vfB);
                    MB_FIN(b, scA, vfA);
                    if (b + 2 < b_hi) MB_QK(b + 2, scA, vfA);
                    MB_FIN(b + 1, scB, vfB);
                }
                if (b < b_hi) MB_FIN(b, scA, vfA);
            }
#undef ATT_VF
#undef MB_QK
#undef MB_FIN
            lsum += __shfl_xor(lsum, 32);
            store_out(o0, o1, 1.0f / lsum, AO + (size_t)(seq_row + P0) * 1024 + 512 + hb * 64, (size_t)1024, (LAS char*)lds + 10 * KVB + wave * VIMG_BYTES, lane);
            __syncthreads();
        }
        }
#undef MB_LOAD
    }
}
}

#define XB_TMO      128
#define XB_XCNT(j)  (256  + 64 * (j))
#define XB_XSUB(j)  (1280 + 64 * (j))
#define XB_XGEN(j)  (2304 + 64 * (j))
#define XB_TOP      3328
#define XB_TOPGEN   3392
#define XCD_BAR_WORDS 3456
#define XB_SPIN_CAP (1u << 18)

__device__ __forceinline__ unsigned xb_ld(unsigned* p)              { return __hip_atomic_load(p, __ATOMIC_RELAXED, __HIP_MEMORY_SCOPE_AGENT); }
__device__ __forceinline__ unsigned xb_add(unsigned* p, unsigned v) { return __hip_atomic_fetch_add(p, v, __ATOMIC_RELAXED, __HIP_MEMORY_SCOPE_AGENT); }
__device__ __forceinline__ unsigned xb_xcc_id() { return (unsigned)__builtin_amdgcn_s_getreg((3 << 11) | 20) & 0xFu; }
#define XB_SPIN(cond, bar) do { unsigned _sp = 0; while (cond) { __builtin_amdgcn_s_sleep(1); \
    if ((++_sp & 255u) == 0u) { if (xb_ld(&(bar)[XB_TMO])) break; if (_sp > XB_SPIN_CAP) { atomicAdd(&(bar)[XB_TMO], 1u); break; } } } } while (0)

struct XcdBarrier {
    unsigned* bar; unsigned x;
    volatile LAS unsigned* st;
};

__device__ __forceinline__ XcdBarrier xcd_barrier_post(unsigned* bar, volatile LAS unsigned* st) {
    XcdBarrier b; b.bar = bar; b.x = xb_xcc_id(); b.st = st;
    if (threadIdx.x == 0) (void)xb_add(&bar[XB_XCNT(b.x)], 1u);
    return b;
}
__device__ __forceinline__ void xcd_barrier_complete(unsigned* bar, unsigned x, unsigned& nloc, unsigned& nx) {
    const unsigned G = gridDim.x * gridDim.y * gridDim.z;
    unsigned sum, cnt, mine, sp = 0u;
    for (;;) {
        sum = 0u; cnt = 0u; mine = 0u;
#pragma unroll
        for (unsigned j = 0; j < 16; ++j) { const unsigned c = xb_ld(&bar[XB_XCNT(j)]); sum += c; cnt += (c > 0u) ? 1u : 0u; mine = (j == x) ? c : mine; }
        if (sum == G) break;
        __builtin_amdgcn_s_sleep(1);
        if ((++sp & 255u) == 0u) { if (xb_ld(&bar[XB_TMO])) break; if (sp > XB_SPIN_CAP) { atomicAdd(&bar[XB_TMO], 1u); break; } }
    }
    nloc = mine > 0u ? mine : 1u; nx = cnt > 0u ? cnt : 1u;
}

__device__ __forceinline__ void xcd_barrier(const XcdBarrier& b) {
    asm volatile("s_waitcnt vmcnt(0)" ::: "memory");
    __syncthreads();
    if (threadIdx.x == 0) {
        unsigned* bar = b.bar;
        __builtin_amdgcn_s_waitcnt(0);
        unsigned nloc = b.st[0], nx = b.st[1];
        if (nloc == 0u) { xcd_barrier_complete(bar, b.x, nloc, nx); b.st[0] = nloc; b.st[1] = nx; }
        const unsigned old = xb_add(&bar[XB_XSUB(b.x)], 1u);
        const unsigned gen = old / nloc;
        if (old + 1u == (gen + 1u) * nloc) {
            __builtin_amdgcn_fence(__ATOMIC_RELEASE, "agent");
            asm volatile("s_waitcnt vmcnt(0)" ::: "memory");
            const unsigned og = xb_add(&bar[XB_TOP], 1u);
            const unsigned tg = og / nx;
            if (og + 1u == (tg + 1u) * nx) xb_add(&bar[XB_TOPGEN], 1u);
            else XB_SPIN(xb_ld(&bar[XB_TOPGEN]) == tg, bar);
            __builtin_amdgcn_fence(__ATOMIC_ACQUIRE, "agent");
            xb_add(&bar[XB_XGEN(b.x)], 1u);
            asm volatile("s_waitcnt vmcnt(0)" ::: "memory");
        } else {
            XB_SPIN(xb_ld(&bar[XB_XGEN(b.x)]) == gen, bar);
            __builtin_amdgcn_fence(__ATOMIC_ACQUIRE, "agent");
            asm volatile("s_waitcnt vmcnt(0)" ::: "memory");
        }
    }
    __syncthreads();
}

struct Args { const float* in[14]; float* out; unsigned char* ws; int ph_lo, ph_hi; };
__global__ void __launch_bounds__(NWAVES * 64, 2) hymba_fwd(Args args) {
    extern __shared__ __attribute__((aligned(16))) unsigned char lds_raw[];
    cg::grid_group grid = cg::this_grid();
    LAS unsigned char* lds = (LAS unsigned char*)lds_raw;
    const int tid = threadIdx.x, lane = tid & 63, wave = __builtin_amdgcn_readfirstlane(tid >> 6);
    const int G = gridDim.x, bx = blockIdx.x;
    const int vcu = (G % 8 == 0) ? (bx % 8) * (G / 8) + bx / 8 : bx;
    const int gw = vcu * NWAVES + wave, NGW = G * NWAVES;
    unsigned char* ws = args.ws;
    const float* xp = args.in[0]; const float* xs = args.in[1]; const float* attn_norm = args.in[2]; const float* w_in = args.in[3];
    const float* qnorm_a = args.in[4]; const float* knorm_a = args.in[5]; const float* qnorm_b = args.in[6]; const float* knorm_b = args.in[7];
    const float* sink_b = args.in[8]; const float* w_out = args.in[9]; const float* ffn_norm = args.in[10]; const float* w_gate = args.in[11];
    const float* w_up = args.in[12]; const float* w_down = args.in[13];
    float* rowss = (float*)(ws + WS_ROWSS); float* cosT = (float*)(ws + WS_COS); float* sinT = (float*)(ws + WS_SIN);
    bf16* Win_t = (bf16*)(ws + WS_WIN); bf16* Wout_t = (bf16*)(ws + WS_WOUT); bf16* Wgu_t = (bf16*)(ws + WS_WGU); bf16* Wdn_t = (bf16*)(ws + WS_WDN);
    bf16* XN = (bf16*)(ws + WS_XN); bf16* AO = XN; bf16* QKV = (bf16*)(ws + WS_QKV); bf16* HB = (bf16*)(ws + WS_H); bf16* XB = (bf16*)(ws + WS_XB);
    const int lo = args.ph_lo, hi = args.ph_hi;
    volatile LAS unsigned* bst = (volatile LAS unsigned*)(lds + LDS_BYTES - 64);
    if (tid < 16) ((LAS unsigned*)(lds + LDS_BYTES - 64))[tid] = 0u;
    __syncthreads();
    XcdBarrier xbar = xcd_barrier_post((unsigned*)(ws + WS_BAR), bst);
    if (lo < 0) grid.sync();
#define IN(k) (lo <= (k) && (k) < hi)
#define SEAM(k) do { if (IN(k) && IN((k) + 1)) xcd_barrier(xbar); } while (0)

    if (IN(0)) {
        LAS float* scr = (LAS float*)(lds + wave * 16384);
        constexpr int I_IN = 16 * 72, I_OUT = 16 * 32, I_G = 16 * 88, I_D = 44 * 32, NITEMS = I_IN + I_OUT + 2 * I_G + I_D;
        for (int it = gw; it < NITEMS; it += NGW) {
            int r = it;
            if (r < I_IN) { const int kb = r / 72, nb = r % 72, n0 = nb * 32; const int dst = 256 * (n0 >> 8) + 128 * ((n0 & 63) >> 5) + 32 * ((n0 & 255) >> 6);
                p0_transpose_item(w_in, D, NIN, Win_t, dst, nullptr, scr, kb, nb, lane); continue; } r -= I_IN;
            if (r < I_OUT) { const int kb = r / 32, nb = r % 32; p0_transpose_item(w_out, D, D, Wout_t, nb * 32, nullptr, scr, kb, nb, lane); continue; } r -= I_OUT;
            if (r < I_G) { const int kb = r / 88, nb = r % 88, n0 = nb * 32; p0_transpose_item(w_gate, D, DFF, Wgu_t, 256 * (n0 >> 7) + (n0 & 127), ffn_norm, scr, kb, nb, lane); continue; } r -= I_G;
            if (r < I_G) { const int kb = r / 88, nb = r % 88, n0 = nb * 32; p0_transpose_item(w_up, D, DFF, Wgu_t, 256 * (n0 >> 7) + 128 + (n0 & 127), ffn_norm, scr, kb, nb, lane); continue; } r -= I_G;
            { const int kb = r / 32, nb = r % 32; p0_transpose_item(w_down, DFF, D, Wdn_t, nb * 32, nullptr, scr, kb, nb, lane); }
        }
        const int gt = gw * 64 + lane, NGT = NGW * 64;
        for (int i = gt; i < SEQ_P * 32; i += NGT) { float c, s; rope_entry(i >> 5, i & 31, c, s); cosT[i] = c; sinT[i] = s; }
        for (int i = gt; i < M; i += NGT) rowss[i] = 0.f;
        for (int m0 = gw; m0 < M; m0 += 4 * NGW) {
            f32x4 v[4][4]; float ssq[4];
#pragma unroll
            for (int q = 0; q < 4; ++q) { const int m = m0 + q * NGW; const int mm = m < M ? m : M - 1;
                const float* xrow = mm < ROWS_P ? xp + (size_t)mm * D : xs + (size_t)(mm - ROWS_P) * D;
                const f32x4* xr = (const f32x4*)xrow + lane;
#pragma unroll
                for (int j = 0; j < 4; ++j) v[q][j] = xr[64 * j]; }
            const f32x4* gr = (const f32x4*)attn_norm + lane;
#pragma unroll
            for (int q = 0; q < 4; ++q) { float s = 0.f;
#pragma unroll
                for (int j = 0; j < 4; ++j) s += (v[q][j].x * v[q][j].x + v[q][j].y * v[q][j].y) + (v[q][j].z * v[q][j].z + v[q][j].w * v[q][j].w);
                ssq[q] = s; }
#pragma unroll
            for (int q = 0; q < 4; ++q) { const int m = m0 + q * NGW; if (m >= M) continue;
                const float rstd = 1.f / sqrtf(wave_sum(ssq[q]) * (1.f / D) + 1e-6f);
                unsigned long long* o8 = (unsigned long long*)(XN + (size_t)m * D) + lane;
#pragma unroll
                for (int j = 0; j < 4; ++j) { const f32x4 g = gr[64 * j]; o8[64 * j] = (unsigned long long)pk2(v[q][j].x * rstd * g.x, v[q][j].y * rstd * g.y) | ((unsigned long long)pk2(v[q][j].z * rstd * g.z, v[q][j].w * rstd * g.w) << 32); } }
        }
        __syncthreads();
    }
    SEAM(0);
    if (IN(1)) {
        pg8::Gemm g{XN, Win_t, M, NIN, D}; pg8::StaticOrder S; S.init(M, NIN, G, bx);
        pg8::EpiQKV E{QKV, cosT, sinT, qnorm_a, knorm_a, qnorm_b, knorm_b};
        pg8::gemm_phase<pg8::EpiQKV, pg8::StaticOrder, PG8_ALIGN, PG8_SP2>(lds, g, S, E);
    }
    SEAM(1);
    if (IN(2)) att::attention_phase(QKV, AO, sink_b, lds, vcu, G, wave, lane);
    SEAM(2);
    if (IN(3)) {
        pg8::Gemm g{AO, Wout_t, M, D, D}; pg8::StaticOrder S; S.init(M, D, G, bx);
        pg8::EpiOut E{xp, xs, XB, rowss};
        pg8::gemm_phase<pg8::EpiOut, pg8::StaticOrder, PG8_ALIGN, PG8_SP2>(lds, g, S, E);
    }
    SEAM(3);
    if (IN(4)) {
        pg8::Gemm g{XB, Wgu_t, M, NGU, D}; pg8::StaticOrder S; S.init(M, NGU, G, bx);
        pg8::EpiGU E{HB, rowss};
        pg8::gemm_phase<pg8::EpiGU, pg8::StaticOrder, PG8_ALIGN, PG8_SP2>(lds, g, S, E);
    }
    SEAM(4);
    if (IN(5)) {
        pg8::Gemm g{HB, Wdn_t, M, D, DFF}; pg8::StaticOrder S; S.init(M, D, G, bx);
        pg8::EpiDown E{args.out, XB};
        pg8::gemm_phase<pg8::EpiDown, pg8::StaticOrder, PG8_ALIGN, PG8_SP2>(lds, g, S, E);
    }
#undef IN
#undef SEAM
}

#ifndef MK_N_LAUNCHES
#define MK_N_LAUNCHES 1
#endif
extern "C" void kernel_launch(void* const* d_in, const int* in_sizes, int n_in, void* d_out, int out_size, void* d_ws, size_t ws_size, hipStream_t stream) {
    static int grid = 0;
    if (grid == 0) {
        if (n_in != 14 || out_size != M * D || ws_size < WS_END) { fprintf(stderr, "kernel_launch: unexpected shapes (n_in %d, out %d, ws %zu); nothing launched\n", n_in, out_size, ws_size); grid = -1; return; }
        int dev = 0, cus = 0, per_cu = 0;
        if (hipGetDevice(&dev) != hipSuccess || hipDeviceGetAttribute(&cus, hipDeviceAttributeMultiprocessorCount, dev) != hipSuccess) { grid = -1; return; }
        if (hipFuncSetAttribute((const void*)hymba_fwd, hipFuncAttributeMaxDynamicSharedMemorySize, LDS_BYTES) != hipSuccess) { fprintf(stderr, "kernel_launch: hipFuncSetAttribute failed\n"); grid = -1; return; }
        if (hipOccupancyMaxActiveBlocksPerMultiprocessor(&per_cu, (const void*)hymba_fwd, NWAVES * 64, LDS_BYTES) != hipSuccess || per_cu < 1) { fprintf(stderr, "kernel_launch: occupancy query says %d\n", per_cu); per_cu = 1; }
        (void)hipGetLastError();
        grid = cus * 1;
    }
    if (grid < 0) return;
    if (hipMemsetAsync((char*)d_ws + WS_BAR, 0, WS_BAR_BYTES, stream) != hipSuccess) { fprintf(stderr, "kernel_launch: hipMemsetAsync of the barrier words failed; nothing launched\n"); return; }
    Args a{};
    for (int i = 0; i < 14; ++i) a.in[i] = (const float*)d_in[i];
    a.out = (float*)d_out; a.ws = (unsigned char*)d_ws;
    for (int li = 0; li < MK_N_LAUNCHES; ++li) {
        if (MK_N_LAUNCHES == 1) { a.ph_lo = 0; a.ph_hi = 6; } else { a.ph_lo = li; a.ph_hi = li + 1; }
        void* kargs[] = {&a};
        const hipError_t e = hipLaunchCooperativeKernel((const void*)hymba_fwd, dim3(grid), dim3(NWAVES * 64), kargs, LDS_BYTES, stream);
        if (e != hipSuccess) { fprintf(stderr, "kernel_launch: cooperative launch %d failed: %s (grid %d)\n", li, hipGetErrorString(e), grid); break; }
    }
}
```

```cpp
#include <hip/hip_runtime.h>
#include <hip/hip_cooperative_groups.h>
#include <cstdio>
#include <cstdint>
namespace cg = cooperative_groups;
namespace pg8 {
#define PG8_LAS __attribute__((address_space(3)))
typedef unsigned short bf16_t;
typedef short bf16x8 __attribute__((ext_vector_type(8)));
typedef float f32x4 __attribute__((ext_vector_type(4)));
typedef unsigned u32x4 __attribute__((ext_vector_type(4)));
constexpr int BM = 256, BK = 64, HALF = 128, HTB = HALF * BK * 2  , STAGE_BYTES = 8 * HTB, NXCD = 8, WGM = 8;

__host__ __device__ __forceinline__ int lds_byte(int r, int c) { const int st = (r >> 4) * 2 + (c >> 5), rr = r & 15, cc = c & 31, ob = rr * 64 + cc * 2; return st * 1024 + (ob ^ (((ob >> 9) & 1) << 5)); }
__host__ __device__ __forceinline__ void stage_rc(int b, int& R, int& C) { const int st = b / 1024, sb = b % 1024, swz = sb ^ (((sb >> 9) & 1) << 5); R = (st >> 1) * 16 + swz / 64; C = (st & 1) * 32 + (swz % 64) / 2; }
__host__ __device__ __forceinline__ int perm32(int rho) { const int n = rho >> 4, i = rho & 15; return 8 * (i >> 2) + 4 * n + (i & 3); }

struct Unit { int pm, pn; };
struct Gemm { const bf16_t* A; const bf16_t* Bt; int M, N, K; };

struct StaticOrder {
    int nM, nN, nwg, G, c;
    __host__ __device__ void init(int M, int N, int G_, int c_) { nM = M / BM; nN = N / BM; nwg = nM * nN; G = G_; c = c_; }
    __host__ __device__ bool next(int i, Unit& u) const {
        const long L = (long)i * G + c; if (L >= nwg) return false;
        int wgid = (int)L; { const int q = nwg / NXCD, r = nwg % NXCD, xcd = wgid % NXCD, off = wgid / NXCD; wgid = (xcd < r ? xcd * (q + 1) : r * (q + 1) + (xcd - r) * q) + off; }
        const int nig = WGM * nN, gid = wgid / nig, fm = gid * WGM, gsz = (nM - fm) < WGM ? (nM - fm) : WGM;
        u.pm = fm + ((wgid % nig) % gsz); u.pn = (wgid % nig) / gsz; return true;
    }
    __device__ __forceinline__ void a_ready(const Unit&) const {}
    __device__ __forceinline__ void done(const Unit&) const {}
};

typedef float f32x2 __attribute__((ext_vector_type(2)));
typedef __bf16 bf16x2v __attribute__((ext_vector_type(2)));
__device__ __forceinline__ unsigned cvt_pk_bf16(float lo, float hi) { f32x2 v = {lo, hi}; bf16x2v b = __builtin_convertvector(v, bf16x2v); return __builtin_bit_cast(unsigned, b); }
template <class Epi, class Sched, bool ALIGN_EPI = false, bool SP2 = false>
__device__ __forceinline__ void gemm_phase(PG8_LAS unsigned char* lds, const Gemm g, const Sched& S, const Epi& E) {
    const int tid = threadIdx.x, wid = __builtin_amdgcn_readfirstlane(tid >> 6), lane = tid & 63, wr = wid >> 2, wc = wid & 3, fr = lane & 15, fq = lane >> 4;
    const int K = g.K, nt = K / BK;
    unsigned voffA[2], voffB[2];
#pragma unroll
    for (int i = 0; i < 2; ++i) { int R, C; stage_rc(tid * 16 + i * 8192, R, C); const int Rb = Epi::PERM ? ((R & ~31) + perm32(R & 31)) : R;
        voffA[i] = (unsigned)(R * K + C) * 2u; voffB[i] = (unsigned)(Rb * K + C) * 2u; }
    const size_t kstep = (size_t)(BK * 2);
    const size_t hstep = (size_t)HALF * K * 2;
    const size_t tstep = 2 * hstep;
    const unsigned ldsw = (unsigned)wid * 1024u;
    const int aoff = lds_byte(wr * 64 + fr, fq * 8), boff = lds_byte(wc * 32 + fr, fq * 8);
#define PG8_SA(b, h) (((b) * 2 + (h)) * HTB)
#define PG8_SB(b, h) ((4 + (b) * 2 + (h)) * HTB)
#define PG8_STAGE(bufoff, gbase, voff) do { _Pragma("unroll") for (int _i = 0; _i < 2; ++_i) \
        __builtin_amdgcn_global_load_lds((const unsigned*)((const char*)(gbase) + (voff)[_i]), (PG8_LAS unsigned*)(lds + (bufoff) + ldsw + _i * 8192), 16, 0, 0); } while (0)
#define PG8_LDA(dst, b, h) do { _Pragma("unroll") for (int m = 0; m < 4; ++m) _Pragma("unroll") for (int k = 0; k < 2; ++k) dst[m][k] = *(const PG8_LAS bf16x8*)(lds + PG8_SA(b, h) + aoff + m * 2048 + k * 1024); } while (0)
#define PG8_LDB(dst, b, h) do { _Pragma("unroll") for (int n = 0; n < 2; ++n) _Pragma("unroll") for (int k = 0; k < 2; ++k) dst[n][k] = *(const PG8_LAS bf16x8*)(lds + PG8_SB(b, h) + boff + n * 2048 + k * 1024); } while (0)
#define PG8_MMA(ai, bj, At, Bt) do { __builtin_amdgcn_s_setprio(1); _Pragma("unroll") for (int m = 0; m < 4; ++m) _Pragma("unroll") for (int n = 0; n < 2; ++n) _Pragma("unroll") for (int k = 0; k < 2; ++k) \
        acc[ai][bj][m][n] = __builtin_amdgcn_mfma_f32_16x16x32_bf16(Bt[n][k], At[m][k], acc[ai][bj][m][n], 0, 0, 0); __builtin_amdgcn_s_setprio(0); } while (0)
#define PG8_WAIT_V(n) asm volatile("s_waitcnt vmcnt(" #n ")" ::: "memory")
#define PG8_WAIT_L(n) asm volatile("s_waitcnt lgkmcnt(" #n ")" ::: "memory")
#define PG8_BAR __builtin_amdgcn_s_barrier()
#define PG8_SCHED __builtin_amdgcn_sched_barrier(0)
    Unit cur, nxt; int ui = 0;
    if (!S.next(0, cur)) return;
    f32x4 acc[2][2][4][2];
#pragma unroll
    for (int a = 0; a < 2; ++a)
#pragma unroll
        for (int b = 0; b < 2; ++b)
#pragma unroll
            for (int m = 0; m < 4; ++m)
#pragma unroll
                for (int n = 0; n < 2; ++n) acc[a][b][m][n] = (f32x4){0.f, 0.f, 0.f, 0.f};
    bf16x8 At[4][2], B0[2][2], B1[2][2];
    const char* cA = (const char*)g.A + (size_t)cur.pm * tstep; const char* cB = (const char*)g.Bt + (size_t)cur.pn * tstep;
    S.a_ready(cur);
    if constexpr (SP2) {
        PG8_STAGE(PG8_SB(0, 0), cB, voffB); PG8_STAGE(PG8_SB(0, 1), cB + hstep, voffB); PG8_STAGE(PG8_SA(0, 0), cA, voffA); PG8_STAGE(PG8_SA(0, 1), cA + hstep, voffA);
        if (wr == 1) PG8_BAR;
        PG8_WAIT_V(2); PG8_BAR;
        PG8_STAGE(PG8_SB(1, 0), cB + kstep, voffB); PG8_STAGE(PG8_SA(1, 0), cA + kstep, voffA); PG8_STAGE(PG8_SB(1, 1), cB + hstep + kstep, voffB);
        PG8_WAIT_V(6); PG8_BAR;
    } else {
        PG8_STAGE(PG8_SB(0, 0), cB, voffB); PG8_STAGE(PG8_SA(0, 0), cA, voffA); PG8_STAGE(PG8_SB(0, 1), cB + hstep, voffB); PG8_STAGE(PG8_SA(0, 1), cA + hstep, voffA);
        if (wr == 1) PG8_BAR;
        PG8_WAIT_V(4); PG8_BAR;
        PG8_STAGE(PG8_SB(1, 0), cB + kstep, voffB); PG8_STAGE(PG8_SA(1, 0), cA + kstep, voffA); PG8_STAGE(PG8_SB(1, 1), cB + hstep + kstep, voffB);
        PG8_WAIT_V(6); PG8_BAR;
    }
    for (;;) {
        const bool has_next = S.next(ui + 1, nxt);
        const char* nA = has_next ? (const char*)g.A + (size_t)nxt.pm * tstep : cA; const char* nB = has_next ? (const char*)g.Bt + (size_t)nxt.pn * tstep : cB;
        for (int t = 0; t < nt; t += 2) {
            const bool last = (t == nt - 2);
            const char* a1 = cA + (size_t)(t + 1) * kstep;
            const char* a2 = last ? nA : cA + (size_t)(t + 2) * kstep; const char* b2 = last ? nB : cB + (size_t)(t + 2) * kstep;
            const char* a3 = a2 + kstep; const char* b3 = b2 + kstep;
            if (last && has_next) S.a_ready(nxt);
            if constexpr (SP2) {
            PG8_LDB(B0, 0, 0); PG8_LDB(B1, 0, 1); PG8_SCHED; PG8_LDA(At, 0, 0); PG8_STAGE(PG8_SA(1, 1), a1 + hstep, voffA);
            PG8_WAIT_V(8); PG8_WAIT_L(0); PG8_BAR; PG8_MMA(0, 0, At, B0); PG8_MMA(0, 1, At, B1); PG8_BAR; PG8_SCHED;
            PG8_LDA(At, 0, 1); PG8_STAGE(PG8_SB(0, 0), b2, voffB); PG8_STAGE(PG8_SB(0, 1), b2 + hstep, voffB); PG8_STAGE(PG8_SA(0, 0), a2, voffA);
            PG8_WAIT_V(8); PG8_WAIT_L(0); PG8_BAR; PG8_MMA(1, 0, At, B0); PG8_MMA(1, 1, At, B1); PG8_BAR; PG8_SCHED;
            PG8_LDB(B0, 1, 0); PG8_LDB(B1, 1, 1); PG8_SCHED; PG8_LDA(At, 1, 0); PG8_STAGE(PG8_SA(0, 1), a2 + hstep, voffA);
            PG8_WAIT_V(8); PG8_WAIT_L(0); PG8_BAR; PG8_MMA(0, 0, At, B0); PG8_MMA(0, 1, At, B1); PG8_BAR; PG8_SCHED;
            PG8_LDA(At, 1, 1); PG8_STAGE(PG8_SB(1, 0), b3, voffB); PG8_STAGE(PG8_SB(1, 1), b3 + hstep, voffB); PG8_STAGE(PG8_SA(1, 0), a3, voffA);
            PG8_WAIT_V(8); PG8_WAIT_L(0); PG8_BAR; PG8_MMA(1, 0, At, B0); PG8_MMA(1, 1, At, B1); PG8_BAR; PG8_SCHED;
            } else {
            PG8_LDB(B0, 0, 0); PG8_SCHED; PG8_LDA(At, 0, 0); PG8_STAGE(PG8_SA(1, 1), a1 + hstep, voffA);
            PG8_WAIT_L(8); PG8_BAR; PG8_WAIT_L(0); PG8_MMA(0, 0, At, B0); PG8_BAR; PG8_SCHED;
            PG8_LDB(B1, 0, 1); PG8_STAGE(PG8_SB(0, 0), b2, voffB);
            PG8_BAR; PG8_WAIT_L(0); PG8_MMA(0, 1, At, B1); PG8_BAR;
            PG8_LDA(At, 0, 1); PG8_STAGE(PG8_SA(0, 0), a2, voffA);
            PG8_BAR; PG8_WAIT_L(0); PG8_MMA(1, 0, At, B0); PG8_BAR; PG8_SCHED;
            PG8_STAGE(PG8_SB(0, 1), b2 + hstep, voffB);
            PG8_WAIT_V(6); PG8_BAR; PG8_MMA(1, 1, At, B1); PG8_BAR;
            PG8_LDB(B0, 1, 0); PG8_SCHED; PG8_LDA(At, 1, 0); PG8_STAGE(PG8_SA(0, 1), a2 + hstep, voffA);
            PG8_WAIT_L(8); PG8_BAR; PG8_WAIT_L(0); PG8_MMA(0, 0, At, B0); PG8_BAR; PG8_SCHED;
            PG8_LDB(B1, 1, 1); PG8_STAGE(PG8_SB(1, 0), b3, voffB);
            PG8_BAR; PG8_WAIT_L(0); PG8_MMA(0, 1, At, B1); PG8_BAR;
            PG8_LDA(At, 1, 1); PG8_STAGE(PG8_SA(1, 0), a3, voffA);
            PG8_BAR; PG8_WAIT_L(0); PG8_MMA(1, 0, At, B0); PG8_BAR; PG8_SCHED;
            PG8_STAGE(PG8_SB(1, 1), b3 + hstep, voffB);
            PG8_WAIT_V(6); PG8_BAR; PG8_MMA(1, 1, At, B1); PG8_BAR;
            }
        }
        if constexpr (ALIGN_EPI) { if (wr == 0) PG8_BAR; }
        if constexpr (!Epi::AFTER_DRAIN) { E(acc, cur, wr, wc, fr, fq); S.done(cur); }
        if (!has_next) break;
#pragma unroll
        for (int a = 0; a < 2; ++a)
#pragma unroll
            for (int b = 0; b < 2; ++b)
#pragma unroll
                for (int m = 0; m < 4; ++m)
#pragma unroll
                    for (int n = 0; n < 2; ++n) acc[a][b][m][n] = (f32x4){0.f, 0.f, 0.f, 0.f};
        cur = nxt; cA = nA; cB = nB; ++ui;
        if constexpr (ALIGN_EPI) { if (wr == 1) PG8_BAR; }
    }
    PG8_WAIT_V(0);
    if constexpr (!ALIGN_EPI) { if (wr == 0) PG8_BAR; }
    PG8_BAR;
    if constexpr (Epi::AFTER_DRAIN) { E.fused(acc, cur, wr, wc, fr, fq, lds, wid, lane); S.done(cur); }
#undef PG8_SA
#undef PG8_SB
#undef PG8_STAGE
#undef PG8_LDA
#undef PG8_LDB
#undef PG8_MMA
#undef PG8_WAIT_V
#undef PG8_WAIT_L
#undef PG8_BAR
#undef PG8_SCHED
}
}

namespace pg8 {
constexpr int ROWS_P = 32768, SEQ_P = 16384, SEQ_S = 2048;
constexpr float QSCALE = 0.125f * 1.4426950408889634f;
constexpr float NORM_EPS = 1e-6f;
constexpr size_t HS_QKV = (size_t)(98304 + 98304 / 16) * 64;
__device__ __forceinline__ float dot4(const f32x4 a) { return (a[0] * a[0] + a[1] * a[1]) + (a[2] * a[2] + a[3] * a[3]); }
__device__ __forceinline__ float rows4_sum(float v) {
    const unsigned u = __builtin_bit_cast(unsigned, v);
    auto a = __builtin_amdgcn_permlane16_swap(u, u, false, false);
    const float s16 = __builtin_bit_cast(float, (unsigned)a[0]) + __builtin_bit_cast(float, (unsigned)a[1]);
    const unsigned w = __builtin_bit_cast(unsigned, s16);
    auto b = __builtin_amdgcn_permlane32_swap(w, w, false, false);
    return __builtin_bit_cast(float, (unsigned)b[0]) + __builtin_bit_cast(float, (unsigned)b[1]);
}

struct EpiQKV {
    static constexpr bool PERM = true, AFTER_DRAIN = false;
    bf16_t* O; const float* cosT; const float* sinT; const float* gqa; const float* gka; const float* gqb; const float* gkb;
    __device__ __forceinline__ void operator()(const f32x4 (&acc)[2][2][4][2], const Unit& u, int wr, int wc, int fr, int fq) const {
        const int pn = u.pn;
        const float* g = nullptr; float sc = 1.f;
        if (pn < 2) { g = gqa; sc = QSCALE; } else if (pn < 4) { g = gka; } else if (pn < 6) { } else if (pn < 8) { g = gqb; sc = QSCALE; } else if (wc < 2) { g = gkb; }
        if (g) body<true>(acc, u, wr, wc, fr, fq, g, sc); else body<false>(acc, u, wr, wc, fr, fq, g, sc);
    }
    template <bool ROPE>
    __device__ __forceinline__ void body(const f32x4 (&acc)[2][2][4][2], const Unit& u, int wr, int wc, int fr, int fq, const float* g, float sc) const {
        const int pn = u.pn;
        f32x4 gv[2][2];
#pragma unroll
        for (int bj = 0; bj < 2; ++bj)
#pragma unroll
            for (int n = 0; n < 2; ++n) { if constexpr (ROPE) gv[bj][n] = *(const f32x4*)(g + 32 * bj + 8 * fq + 4 * n); else gv[bj][n] = (f32x4){1.f, 1.f, 1.f, 1.f}; }
        f32x4 tb[1][4];
#define QKV_LDT(k, slot) do { if constexpr (ROPE) { const int row_ = u.pm * BM + ((k) >> 2) * HALF + wr * 64 + ((k) & 3) * 16 + fr; const int pos_ = row_ < ROWS_P ? (row_ & (SEQ_P - 1)) : (row_ & (SEQ_S - 1)); \
            tb[slot][0] = *(const f32x4*)(cosT + pos_ * 32 + 8 * fq); tb[slot][1] = *(const f32x4*)(cosT + pos_ * 32 + 8 * fq + 4); \
            tb[slot][2] = *(const f32x4*)(sinT + pos_ * 32 + 8 * fq); tb[slot][3] = *(const f32x4*)(sinT + pos_ * 32 + 8 * fq + 4); } } while (0)
        QKV_LDT(0, 0);
#pragma unroll
        for (int k = 0; k < 8; ++k) {
            const int ai = k >> 2, m = k & 3;
            const int row = u.pm * BM + ai * HALF + wr * 64 + m * 16 + fr;
            f32x4 v00 = acc[ai][0][m][0], v01 = acc[ai][0][m][1], v10 = acc[ai][1][m][0], v11 = acc[ai][1][m][1];
            if constexpr (ROPE) {
                float ss = (dot4(v00) + dot4(v01)) + (dot4(v10) + dot4(v11));
                ss = rows4_sum(ss);
                const float rinv = __builtin_amdgcn_rsqf(ss * (1.0f / 64.0f) + NORM_EPS);
                const f32x4 c0 = tb[0][0], c1 = tb[0][1], s0 = tb[0][2], s1 = tb[0][3];
                const f32x4 y00 = v00 * rinv * gv[0][0], y01 = v01 * rinv * gv[0][1], y10 = v10 * rinv * gv[1][0], y11 = v11 * rinv * gv[1][1];
                v00 = (y00 * c0 - y10 * s0) * sc; v10 = (y10 * c0 + y00 * s0) * sc;
                v01 = (y01 * c1 - y11 * s1) * sc; v11 = (y11 * c1 + y01 * s1) * sc;
            }
            if (k + 1 < 8) { QKV_LDT(k + 1, 0); }
            if constexpr (ROPE) asm volatile("" ::: "memory");
            bf16_t* rowp = O + (size_t)(pn * 4 + wc) * HS_QKV + (size_t)(row + (row >> 4)) * 64 + fq * 8;
            u32x4 w0, w1;
            w0.x = cvt_pk_bf16(v00[0], v00[1]); w0.y = cvt_pk_bf16(v00[2], v00[3]); w0.z = cvt_pk_bf16(v01[0], v01[1]); w0.w = cvt_pk_bf16(v01[2], v01[3]);
            w1.x = cvt_pk_bf16(v10[0], v10[1]); w1.y = cvt_pk_bf16(v10[2], v10[3]); w1.z = cvt_pk_bf16(v11[0], v11[1]); w1.w = cvt_pk_bf16(v11[2], v11[3]);
            *(u32x4*)(rowp) = w0; *(u32x4*)(rowp + 32) = w1;
        }
#undef QKV_LDT
    }
};

struct EpiOut {
    static constexpr bool PERM = true, AFTER_DRAIN = false;
    const float* xp; const float* xs; bf16_t* xb; float* rowss;
    __device__ __forceinline__ void operator()(const f32x4 (&acc)[2][2][4][2], const Unit& u, int wr, int wc, int fr, int fq) const {
        const int row0 = u.pm * BM;
        const float* xin = row0 < ROWS_P ? xp + (size_t)row0 * 1024 : xs + (size_t)(row0 - ROWS_P) * 1024;
        const int colb = u.pn * BM + wc * 32 + fq * 8;
        f32x4 xa[2][2], xc[2][2];
#define OUT_LD(k) do { _Pragma("unroll") for (int mm_ = 0; mm_ < 2; ++mm_) { const int rl_ = ((k) >> 1) * HALF + wr * 64 + (2 * ((k) & 1) + mm_) * 16 + fr; \
            _Pragma("unroll") for (int bj_ = 0; bj_ < 2; ++bj_) { const int col_ = colb + bj_ * HALF; \
                xa[mm_][bj_] = *(const f32x4*)(xin + (size_t)rl_ * 1024 + col_); xc[mm_][bj_] = *(const f32x4*)(xin + (size_t)rl_ * 1024 + col_ + 4); } } } while (0)
        OUT_LD(0);
#pragma unroll
        for (int k = 0; k < 4; ++k) {
            const int ai = k >> 1, mh = k & 1;
            u32x4 w[2][2]; float ssv[2];
#pragma unroll
            for (int mm = 0; mm < 2; ++mm) {
                const int m = 2 * mh + mm;
                float ss = 0.f;
#pragma unroll
                for (int bj = 0; bj < 2; ++bj) {
                    const f32x4 a = xa[mm][bj] + acc[ai][bj][m][0];
                    const f32x4 b = xc[mm][bj] + acc[ai][bj][m][1];
                    ss += dot4(a) + dot4(b);
                    w[mm][bj].x = cvt_pk_bf16(a[0], a[1]); w[mm][bj].y = cvt_pk_bf16(a[2], a[3]); w[mm][bj].z = cvt_pk_bf16(b[0], b[1]); w[mm][bj].w = cvt_pk_bf16(b[2], b[3]);
                }
                ss = rows4_sum(ss);
                ssv[mm] = ss;
            }
            if (k + 1 < 4) { OUT_LD(k + 1); }
            asm volatile("" ::: "memory");
#pragma unroll
            for (int mm = 0; mm < 2; ++mm) {
                const int m = 2 * mh + mm;
                const int rl = ai * HALF + wr * 64 + m * 16 + fr; const size_t row = (size_t)row0 + rl;
#pragma unroll
                for (int bj = 0; bj < 2; ++bj) *(u32x4*)(xb + row * 1024 + colb + bj * HALF) = w[mm][bj];
                if (fq == 0) atomicAdd(rowss + row, ssv[mm]);
            }
        }
#undef OUT_LD
    }
};

struct EpiGU {
    static constexpr bool PERM = true, AFTER_DRAIN = false;
    bf16_t* H; const float* rowss;
    __device__ __forceinline__ void operator()(const f32x4 (&acc)[2][2][4][2], const Unit& u, int wr, int wc, int fr, int fq) const {
        const int colh = u.pn * HALF + wc * 32 + fq * 8;
        float rsv[2][4];
#pragma unroll
        for (int ai = 0; ai < 2; ++ai)
#pragma unroll
            for (int m = 0; m < 4; ++m) rsv[ai][m] = rowss[(size_t)u.pm * BM + ai * HALF + wr * 64 + m * 16 + fr];
#pragma unroll
        for (int ai = 0; ai < 2; ++ai)
#pragma unroll
            for (int m = 0; m < 4; ++m) rsv[ai][m] = __builtin_amdgcn_rsqf(rsv[ai][m] * (1.0f / 1024.0f) + NORM_EPS);
#pragma unroll
        for (int ai = 0; ai < 2; ++ai)
#pragma unroll
            for (int m = 0; m < 4; ++m) {
                const size_t row = (size_t)u.pm * BM + ai * HALF + wr * 64 + m * 16 + fr;
                const float rstd = rsv[ai][m]; const float k1 = -rstd * 1.4426950408889634f, k2 = rstd * rstd;
                float hv[8];
#pragma unroll
                for (int n = 0; n < 2; ++n)
#pragma unroll
                    for (int i = 0; i < 4; ++i) {
                        const float ga = acc[ai][0][m][n][i], ua = acc[ai][1][m][n][i];
                        const float e = __builtin_amdgcn_exp2f(ga * k1);
                        hv[n * 4 + i] = (ga * ua) * (k2 * __builtin_amdgcn_rcpf(1.0f + e));
                    }
                u32x4 w; w.x = cvt_pk_bf16(hv[0], hv[1]); w.y = cvt_pk_bf16(hv[2], hv[3]); w.z = cvt_pk_bf16(hv[4], hv[5]); w.w = cvt_pk_bf16(hv[6], hv[7]);
                *(u32x4*)(H + row * 2816 + colh) = w;
            }
    }
};

struct EpiDown {
    static constexpr bool PERM = true, AFTER_DRAIN = false;
    float* out; const bf16_t* xb;
    __device__ __forceinline__ void operator()(const f32x4 (&acc)[2][2][4][2], const Unit& u, int wr, int wc, int fr, int fq) const {
        const int colb = u.pn * BM + wc * 32 + fq * 8;
        u32x4 xw[2][2];
#define DN_LD(k) do { _Pragma("unroll") for (int mm_ = 0; mm_ < 2; ++mm_) { const size_t row_ = (size_t)u.pm * BM + ((k) >> 1) * HALF + wr * 64 + (2 * ((k) & 1) + mm_) * 16 + fr; \
            _Pragma("unroll") for (int bj_ = 0; bj_ < 2; ++bj_) xw[mm_][bj_] = *(const u32x4*)(xb + row_ * 1024 + colb + bj_ * HALF); } } while (0)
        DN_LD(0);
#pragma unroll
        for (int k = 0; k < 4; ++k) {
            const int ai = k >> 1, mh = k & 1;
            f32x4 ra[2][2], rb[2][2];
#pragma unroll
            for (int mm = 0; mm < 2; ++mm) {
                const int m = 2 * mh + mm;
#pragma unroll
                for (int bj = 0; bj < 2; ++bj) {
                    const u32x4 w = xw[mm][bj];
                    f32x4 xa, xc;
                    xa[0] = __builtin_bit_cast(float, w.x << 16); xa[1] = __builtin_bit_cast(float, w.x & 0xffff0000u); xa[2] = __builtin_bit_cast(float, w.y << 16); xa[3] = __builtin_bit_cast(float, w.y & 0xffff0000u);
                    xc[0] = __builtin_bit_cast(float, w.z << 16); xc[1] = __builtin_bit_cast(float, w.z & 0xffff0000u); xc[2] = __builtin_bit_cast(float, w.w << 16); xc[3] = __builtin_bit_cast(float, w.w & 0xffff0000u);
                    ra[mm][bj] = xa + acc[ai][bj][m][0]; rb[mm][bj] = xc + acc[ai][bj][m][1];
                }
            }
            if (k + 1 < 4) { DN_LD(k + 1); }
            asm volatile("" ::: "memory");
#pragma unroll
            for (int mm = 0; mm < 2; ++mm) {
                const size_t row = (size_t)u.pm * BM + ai * HALF + wr * 64 + (2 * mh + mm) * 16 + fr;
#pragma unroll
                for (int bj = 0; bj < 2; ++bj) { float* p = out + row * 1024 + colb + bj * HALF; *(f32x4*)p = ra[mm][bj]; *(f32x4*)(p + 4) = rb[mm][bj]; }
            }
        }
#undef DN_LD
    }
};
}

#ifndef PG8_SP2
#define PG8_SP2 true
#endif
#ifndef PG8_ALIGN
#define PG8_ALIGN true
#endif

constexpr int NWAVES = 8;
constexpr int D = 1024, M = 98304, NIN = 2304, DFF = 2816, NGU = 2 * DFF;
constexpr int ROWS_P = pg8::ROWS_P, SEQ_P = pg8::SEQ_P, SEQ_S = pg8::SEQ_S;
constexpr size_t MiB = 1u << 20;
constexpr size_t WS_ROWSS = 0;
constexpr size_t WS_BAR = 512 * 1024, WS_BAR_BYTES = 16384;
constexpr size_t WS_COS = 1 * MiB, WS_SIN = 3 * MiB;
constexpr size_t WS_WIN = 8 * MiB;
constexpr size_t WS_WOUT = 13 * MiB;
constexpr size_t WS_WGU = 15 * MiB;
constexpr size_t WS_WDN = 26 * MiB;
constexpr size_t WS_XN = 32 * MiB;
constexpr size_t WS_QKV = 232 * MiB;
constexpr size_t WS_H = WS_QKV;
constexpr size_t WS_XB = 768 * MiB;
constexpr size_t WS_END = 960 * MiB;
static_assert(WS_XN + (size_t)M * D * 2 <= WS_QKV && WS_H + (size_t)M * DFF * 2 <= WS_XB && WS_XB + (size_t)M * D * 2 <= WS_END, "d_ws map");

constexpr int RING_BYTES = 131072, LDS_BYTES = 147456;

#define GAS __attribute__((address_space(1)))
#define LAS __attribute__((address_space(3)))
typedef unsigned short bf16;
typedef unsigned v4u __attribute__((ext_vector_type(4)));
typedef float f32x4 __attribute__((ext_vector_type(4)));
__device__ __forceinline__ unsigned f2bf(float f) { unsigned u = __builtin_bit_cast(unsigned, f); return (u + 0x7fffu + ((u >> 16) & 1u)) >> 16; }
__device__ __forceinline__ unsigned pk2(float lo, float hi) { return pg8::cvt_pk_bf16(lo, hi); }
__device__ __forceinline__ float wave_sum(float v) {
#pragma unroll
    for (int o = 1; o < 64; o <<= 1) v += __shfl_xor(v, o);
    return v;
}

__device__ __forceinline__ void p0_transpose_item(const float* W, int K, int N, bf16* WT, int dst_row0, const float* gain, LAS float* scr, int kb, int nb, int lane) {
    const int k0 = 64 * kb, n0 = 32 * nb;
#pragma unroll 8
    for (int i = 0; i < 32; ++i) { const int kk = 2 * i + (lane >> 5); float v = W[(size_t)(k0 + kk) * N + n0 + (lane & 31)]; if (gain) v *= gain[k0 + kk]; scr[kk * 33 + (lane & 31)] = v; }
    asm volatile("s_waitcnt lgkmcnt(0)" ::: "memory");
    const int c = lane & 7;
#pragma unroll
    for (int j = 0; j < 4; ++j) { const int n = (lane >> 3) + 8 * j; const LAS float* s = scr + (8 * c) * 33 + n;
        v4u o; o.x = pk2(s[0 * 33], s[1 * 33]); o.y = pk2(s[2 * 33], s[3 * 33]); o.z = pk2(s[4 * 33], s[5 * 33]); o.w = pk2(s[6 * 33], s[7 * 33]);
        *(v4u*)(WT + (size_t)(dst_row0 + n) * K + k0 + 8 * c) = o; }
    asm volatile("s_waitcnt lgkmcnt(0)" ::: "memory");
}

__device__ const float ROPE_INV[32] = {
    1.000000000e+00f, 7.498942614e-01f, 5.623413324e-01f, 4.216965139e-01f, 3.162277639e-01f, 2.371373773e-01f, 1.778279394e-01f, 1.333521307e-01f,
    1.000000015e-01f, 7.498941571e-02f, 5.623413250e-02f, 4.216965288e-02f, 3.162277490e-02f, 2.371373773e-02f, 1.778279431e-02f, 1.333521493e-02f,
    9.999999776e-03f, 7.498941850e-03f, 5.623413250e-03f, 4.216964822e-03f, 3.162277630e-03f, 2.371373586e-03f, 1.778279431e-03f, 1.333521446e-03f,
    1.000000047e-03f, 7.498942432e-04f, 5.623413017e-04f, 4.216965172e-04f, 3.162277571e-04f, 2.371373703e-04f, 1.778279402e-04f, 1.333521504e-04f};

__device__ __forceinline__ void rope_entry(int pos, int j, float& co, float& si) {
    const float ang = (float)pos * ROPE_INV[j];
    const double a = (double)ang;
    const double k = __builtin_rint(a * 0.15915494309189535);
    double r = __builtin_fma(-k, 6.283185307179586, a); r = __builtin_fma(-k, 2.4492935982947064e-16, r);
    const double q = __builtin_rint(r * 0.6366197723675814);
    double x = __builtin_fma(-q, 1.5707963267948966, r); x = __builtin_fma(-q, 6.123233995736766e-17, x);
    const double x2 = x * x;
    const double s = x * (1.0 + x2 * (-1.0 / 6 + x2 * (1.0 / 120 + x2 * (-1.0 / 5040 + x2 * (1.0 / 362880 + x2 * (-1.0 / 39916800 + x2 * (1.0 / 6227020800.0)))))));
    const double c = 1.0 + x2 * (-0.5 + x2 * (1.0 / 24 + x2 * (-1.0 / 720 + x2 * (1.0 / 40320 + x2 * (-1.0 / 3628800 + x2 * (1.0 / 479001600 + x2 * (-1.0 / 87178291200.0)))))));
    const int qi = ((int)q) & 3;
    const double sn = (qi == 0) ? s : (qi == 1) ? c : (qi == 2) ? -s : -c;
    const double cs = (qi == 0) ? c : (qi == 1) ? -s : (qi == 2) ? -c : s;
    co = (float)cs; si = (float)sn;
}

namespace att {
typedef short bf16x8 __attribute__((ext_vector_type(8)));
typedef short s16x4 __attribute__((ext_vector_type(4)));
typedef float f32x16 __attribute__((ext_vector_type(16)));
typedef unsigned u32x4 __attribute__((ext_vector_type(4)));
typedef unsigned u32x2 __attribute__((ext_vector_type(2)));
typedef float f32x2_t __attribute__((ext_vector_type(2))); typedef __bf16 bf16x2_t __attribute__((ext_vector_type(2)));
typedef short v4i16_t __attribute__((ext_vector_type(4)));
constexpr int QP = 64;
constexpr size_t HS = (size_t)(M + M / 16) * 64;
__device__ __forceinline__ size_t rofs(int r) { return (size_t)(r + (r >> 4)) * 64; }
constexpr int VS = 144;
constexpr int VIMG_BYTES = 32 * VS;
constexpr int LDS_O1 = NWAVES * 2 * VIMG_BYTES, O1S = 136, LDS_L1 = LDS_O1 + 512 * O1S, LDS_ATT_END = LDS_L1 + 512 * 4;
static_assert(LDS_ATT_END <= LDS_BYTES, "attention LDS map");
constexpr int N_UNITS_A = (M / 512) * 8, N_ITEMS_B = M / 32 * 8;
#ifndef ATT_REP_A
#define ATT_REP_A 1
#endif
#ifndef ATT_REP_B
#define ATT_REP_B 1
#endif
__device__ __forceinline__ unsigned cvtpk(float lo, float hi) { f32x2_t v = {lo, hi}; bf16x2_t b = __builtin_convertvector(v, bf16x2_t); return __builtin_bit_cast(unsigned, b); }
__device__ __forceinline__ s16x4 vtr(const LAS char* p) { return __builtin_bit_cast(s16x4, __builtin_amdgcn_ds_read_tr16_b64_v4i16((LAS v4i16_t*)p)); }
__device__ __forceinline__ float bflo(unsigned w) { return __builtin_bit_cast(float, w << 16); }
__device__ __forceinline__ float bfhi(unsigned w) { return __builtin_bit_cast(float, w & 0xffff0000u); }

__device__ __forceinline__ f32x16 qk(const bf16x8 (&kf)[4], const bf16x8 (&qf)[4]) {
    f32x16 sc;
#pragma unroll
    for (int r = 0; r < 16; ++r) sc[r] = 0.f;
#pragma unroll
    for (int s = 0; s < 4; ++s) sc = __builtin_amdgcn_mfma_f32_32x32x16_bf16(kf[s], qf[s], sc, 0, 0, 0);
    return sc;
}

__device__ __forceinline__ void tile_finish(f32x16& o0, f32x16& o1, float& lsum, f32x16 sc, const bf16x8 (&vf)[4], bool safe, int tb, int lb, int L) {
    if (!safe) {
#pragma unroll
        for (int r = 0; r < 16; ++r) {
            const int cr = (r & 3) + 8 * (r >> 2);
            const bool ok = ((unsigned)(tb + cr) <= 128u) && ((unsigned)(lb + cr) < (unsigned)L);
            sc[r] = ok ? sc[r] : -INFINITY;
        }
    }
    float p[16];
#pragma unroll
    for (int r = 0; r < 16; ++r) { p[r] = __builtin_amdgcn_exp2f(sc[r]); lsum += p[r]; }
    u32x4 pw0, pw1;
    pw0.x = cvtpk(p[0], p[1]); pw0.y = cvtpk(p[2], p[3]); pw0.z = cvtpk(p[4], p[5]); pw0.w = cvtpk(p[6], p[7]);
    pw1.x = cvtpk(p[8], p[9]); pw1.y = cvtpk(p[10], p[11]); pw1.z = cvtpk(p[12], p[13]); pw1.w = cvtpk(p[14], p[15]);
    const bf16x8 pf0 = __builtin_bit_cast(bf16x8, pw0), pf1 = __builtin_bit_cast(bf16x8, pw1);
    o0 = __builtin_amdgcn_mfma_f32_32x32x16_bf16(vf[0], pf0, o0, 0, 0, 0);
    o1 = __builtin_amdgcn_mfma_f32_32x32x16_bf16(vf[1], pf0, o1, 0, 0, 0);
    o0 = __builtin_amdgcn_mfma_f32_32x32x16_bf16(vf[2], pf1, o0, 0, 0, 0);
    o1 = __builtin_amdgcn_mfma_f32_32x32x16_bf16(vf[3], pf1, o1, 0, 0, 0);
}
__device__ __forceinline__ void tile_block(f32x16& o0, f32x16& o1, float& lsum, const bf16x8 (&qf)[4], const bf16x8 (&kf)[4], const bf16x8 (&vf)[4], bool safe, int tb, int lb, int L) {
    tile_finish(o0, o1, lsum, qk(kf, qf), vf, safe, tb, lb, L);
}
__device__ __forceinline__ void load_kv2(u32x4 (&kn)[4], u32x4 (&vn)[4], const bf16* kbase, const bf16* vbase, int l0, int L, int rho, int shift, int lane) {
#pragma unroll
    for (int c = 0; c < 4; ++c) { int lv = l0 + 8 * c + (lane >> 3); lv = lv < 0 ? 0 : (lv > L - 1 ? L - 1 : lv);
        const size_t ro = rofs(rho + (lv << shift));
        kn[c] = *(const u32x4*)(kbase + ro); vn[c] = *(const u32x4*)(vbase + ro); }
}
__device__ __forceinline__ void pre_kv(u32x4 (&kn)[4], u32x4 (&vn)[4], const bf16* kbase, const bf16* vbase, int lstart, int L, int rho, int shift, int lane) {
    const int b_lo = (lstart < -31) ? ((-lstart) >> 5) : 0;
    load_kv2(kn, vn, kbase, vbase, lstart + 32 * b_lo, L, rho, shift, lane);
}
template <bool DUAL>
__device__ __forceinline__ void run_branch2(f32x16& oA0, f32x16& oA1, float& lsA, const bf16x8 (&qfA)[4], f32x16& oB0, f32x16& oB1, float& lsB, const bf16x8 (&qfB)[4],
                                            const bf16* kbase, const bf16* vbase, int rho, int shift, int L, int lstart, u32x4 (&kn)[4], u32x4 (&vn)[4], LAS char* vimg, int lane) {
    const int qi = lane & 31, hi = lane >> 5;
    const int tqA = qi - 4 * hi, tqB = tqA + 32;
    const int b_lo = (lstart < -31) ? ((-lstart) >> 5) : 0;
    int b_hi = (L - lstart + 31) >> 5; if (b_hi > (DUAL ? 6 : 5)) b_hi = DUAL ? 6 : 5;
    const LAS char* krd = vimg + qi * VS + hi * 16;
    const LAS char* vrd = vimg + VIMG_BYTES + (4 * hi + ((lane & 15) >> 2)) * VS + ((lane >> 4) & 1) * 32 + (lane & 3) * 8;
    LAS char* kwr = vimg + (lane >> 3) * VS + (lane & 7) * 16;
#pragma unroll 1
    for (int b = b_lo; b < b_hi; ++b) {
#pragma unroll
        for (int c = 0; c < 4; ++c) { *(LAS u32x4*)(kwr + c * 8 * VS) = kn[c]; *(LAS u32x4*)(kwr + VIMG_BYTES + c * 8 * VS) = vn[c]; }
        if (b + 1 < b_hi) load_kv2(kn, vn, kbase, vbase, lstart + 32 * (b + 1), L, rho, shift, lane);
        bf16x8 kf[4], vf[4];
#pragma unroll
        for (int s = 0; s < 4; ++s) kf[s] = *(const LAS bf16x8*)(krd + 32 * s);
#define ATT_VF(t, d0) __builtin_shufflevector(vtr(vrd + (16 * (t)) * VS + 64 * (d0)), vtr(vrd + (16 * (t) + 8) * VS + 64 * (d0)), 0, 1, 2, 3, 4, 5, 6, 7)
        vf[0] = ATT_VF(0, 0); vf[1] = ATT_VF(0, 1); vf[2] = ATT_VF(1, 0); vf[3] = ATT_VF(1, 1);
#undef ATT_VF
        const int l0 = lstart + 32 * b;
        const bool inr = (l0 >= 0) && (l0 + 31 < L);
        if (b <= 4) tile_block(oA0, oA1, lsA, qfA, kf, vf, inr && b >= 1 && b <= 3, 32 * b - tqA, l0 + 4 * hi, L);
        if (DUAL && b >= 1) tile_block(oB0, oB1, lsB, qfB, kf, vf, inr && b >= 2 && b <= 4, 32 * b - tqB, l0 + 4 * hi, L);
    }
}

__device__ __forceinline__ void run_branch1(f32x16& o0, f32x16& o1, float& lsum, const bf16x8 (&qf)[4], const bf16* kbase, const bf16* vbase, int rho, int shift, int L, int lstart,
                                            u32x4 (&kn)[4], u32x4 (&vn)[4], LAS char* vimg, int lane) {
    const int qi = lane & 31, hi = lane >> 5;
    const int tq = qi - 4 * hi;
    const int b_lo = (lstart < -31) ? ((-lstart) >> 5) : 0;
    int b_hi = (L - lstart + 31) >> 5; if (b_hi > 5) b_hi = 5;
    const LAS char* krd = vimg + qi * VS + hi * 16;
    const LAS char* vrd = vimg + VIMG_BYTES + (4 * hi + ((lane & 15) >> 2)) * VS + ((lane >> 4) & 1) * 32 + (lane & 3) * 8;
    LAS char* kwr = vimg + (lane >> 3) * VS + (lane & 7) * 16;
#define ATT_VF(t, d0) __builtin_shufflevector(vtr(vrd + (16 * (t)) * VS + 64 * (d0)), vtr(vrd + (16 * (t) + 8) * VS + 64 * (d0)), 0, 1, 2, 3, 4, 5, 6, 7)
#define R1_STAGE_QK(bn, scX, vfX) do { \
        _Pragma("unroll") for (int c = 0; c < 4; ++c) { *(LAS u32x4*)(kwr + c * 8 * VS) = kn[c]; *(LAS u32x4*)(kwr + VIMG_BYTES + c * 8 * VS) = vn[c]; } \
        if ((bn) + 1 < b_hi) load_kv2(kn, vn, kbase, vbase, lstart + 32 * ((bn) + 1), L, rho, shift, lane); \
        bf16x8 kf_[4]; \
        _Pragma("unroll") for (int s = 0; s < 4; ++s) kf_[s] = *(const LAS bf16x8*)(krd + 32 * s); \
        scX = qk(kf_, qf); \
        vfX[0] = ATT_VF(0, 0); vfX[1] = ATT_VF(0, 1); vfX[2] = ATT_VF(1, 0); vfX[3] = ATT_VF(1, 1); } while (0)
#define R1_FIN(bb, scX, vfX) do { const int l0_ = lstart + 32 * (bb); \
        tile_finish(o0, o1, lsum, scX, vfX, (l0_ >= 0) && (l0_ + 31 < L) && (bb) >= 1 && (bb) <= 3, 32 * (bb) - tq, l0_ + 4 * hi, L); } while (0)
    f32x16 scA, scB; bf16x8 vfA[4], vfB[4];
    int b = b_lo;
    R1_STAGE_QK(b, scA, vfA);
#pragma unroll 1
    for (; b + 1 < b_hi; b += 2) {
        R1_STAGE_QK(b + 1, scB, vfB);
        R1_FIN(b, scA, vfA);
        if (b + 2 < b_hi) R1_STAGE_QK(b + 2, scA, vfA);
        R1_FIN(b + 1, scB, vfB);
    }
    if (b < b_hi) R1_FIN(b, scA, vfA);
#undef R1_STAGE_QK
#undef R1_FIN
#undef ATT_VF
}

__device__ __forceinline__ void store_out(const f32x16& o0, const f32x16& o1, float inv, bf16* out0, size_t rstride, LAS char* stg, int lane) {
    const int qi = lane & 31, hi = lane >> 5;
    LAS char* w = stg + qi * VS + 8 * hi;
#pragma unroll
    for (int c = 0; c < 4; ++c) {
        u32x2 w0, w1;
        w0.x = cvtpk(o0[4 * c] * inv, o0[4 * c + 1] * inv); w0.y = cvtpk(o0[4 * c + 2] * inv, o0[4 * c + 3] * inv);
        w1.x = cvtpk(o1[4 * c] * inv, o1[4 * c + 1] * inv); w1.y = cvtpk(o1[4 * c + 2] * inv, o1[4 * c + 3] * inv);
        *(LAS u32x2*)(w + 16 * c) = w0; *(LAS u32x2*)(w + 64 + 16 * c) = w1;
    }
#pragma unroll
    for (int j = 0; j < 4; ++j) {
        const int row = 8 * j + (lane >> 3), ch = lane & 7;
        const u32x4 v = *(const LAS u32x4*)(stg + row * VS + ch * 16);
        *(u32x4*)(out0 + (size_t)row * rstride + ch * 8) = v;
    }
}

__device__ __forceinline__ void attention_phase(const bf16* QKV, bf16* AO, const float* sink, LAS unsigned char* lds, int vcu, int G, int wave, int lane) {
    const int qi = lane & 31, hi = lane >> 5;
    LAS char* vimg = (LAS char*)lds + wave * (2 * VIMG_BYTES);
    LAS char* O1 = (LAS char*)lds + LDS_O1; LAS float* L1 = (LAS float*)((LAS char*)lds + LDS_L1);
    {
    u32x4 kn[4], vn[4]; bf16x8 qA[4], qB[4];
#define QLD(dst, hh, row) do { const bf16* qp_ = QKV + (size_t)(hh) * HS + rofs((int)(row)) + 8 * hi; _Pragma("unroll") for (int s_ = 0; s_ < 4; ++s_) dst[s_] = *(const bf16x8*)(qp_ + 16 * s_); } while (0)
#define UNIT_PARAMS(uu, h, S, seq_row, pc, kb_, vb_) const int h = (uu) / (M / 512); const int rowc_##h = ((uu) % (M / 512)) * 512; const int S = rowc_##h < ROWS_P ? SEQ_P : SEQ_S; \
        const int seq_row = rowc_##h & ~(S - 1), pc = rowc_##h - seq_row; const bf16* kb_ = QKV + rofs(seq_row) + (8 + h) * HS + (lane & 7) * 8; const bf16* vb_ = QKV + rofs(seq_row) + (16 + h) * HS + (lane & 7) * 8
    if (vcu < N_UNITS_A) { UNIT_PARAMS(vcu, h0, S0, sr0, pc0, kb0, vb0); const int P0 = pc0 + 64 * wave;
        QLD(qA, h0, sr0 + P0 + qi); QLD(qB, h0, sr0 + P0 + 32 + qi); pre_kv(kn, vn, kb0, vb0, P0 - 64, S0, 0, 0, lane); }
    for (int u = vcu; u < N_UNITS_A; u += G) {
        UNIT_PARAMS(u, h, S, seq_row, pc, kb_, vb_);
        {
            const int P0 = pc + 64 * wave;
            f32x16 oA0, oA1, oB0, oB1; float lsA = 0.f, lsB = 0.f;
#pragma unroll
            for (int r = 0; r < 16; ++r) { oA0[r] = 0.f; oA1[r] = 0.f; oB0[r] = 0.f; oB1[r] = 0.f; }
            run_branch2<true>(oA0, oA1, lsA, qA, oB0, oB1, lsB, qB, kb_, vb_, 0, 0, S, P0 - 64, kn, vn, vimg, lane);
            { const int P0b = pc + (wave & 3) + 256 * (wave >> 2);
              QLD(qA, h, seq_row + P0b + 4 * qi); QLD(qB, h, seq_row + P0b + 128 + 4 * qi); pre_kv(kn, vn, kb_, vb_, (P0b >> 2) - 64, S >> 2, P0b & 3, 2, lane); }
            lsA += __shfl_xor(lsA, 32); lsB += __shfl_xor(lsB, 32);
            LAS char* orowA = O1 + (64 * wave + qi) * O1S + 8 * hi; LAS char* orowB = orowA + 32 * O1S;
#pragma unroll
            for (int c = 0; c < 4; ++c) {
                u32x2 w0, w1;
                w0.x = cvtpk(oA0[4 * c], oA0[4 * c + 1]); w0.y = cvtpk(oA0[4 * c + 2], oA0[4 * c + 3]);
                w1.x = cvtpk(oA1[4 * c], oA1[4 * c + 1]); w1.y = cvtpk(oA1[4 * c + 2], oA1[4 * c + 3]);
                *(LAS u32x2*)(orowA + 16 * c) = w0; *(LAS u32x2*)(orowA + 64 + 16 * c) = w1;
                w0.x = cvtpk(oB0[4 * c], oB0[4 * c + 1]); w0.y = cvtpk(oB0[4 * c + 2], oB0[4 * c + 3]);
                w1.x = cvtpk(oB1[4 * c], oB1[4 * c + 1]); w1.y = cvtpk(oB1[4 * c + 2], oB1[4 * c + 3]);
                *(LAS u32x2*)(orowB + 16 * c) = w0; *(LAS u32x2*)(orowB + 64 + 16 * c) = w1;
            }
            if (hi == 0) { L1[64 * wave + qi] = lsA; L1[64 * wave + 32 + qi] = lsB; }
        }
        __syncthreads();
        {
            const int c = wave & 3, tp = wave >> 2, P0 = pc + c + 256 * tp;
            f32x16 oA0, oA1, oB0, oB1; float lsA = 0.f, lsB = 0.f;
#pragma unroll
            for (int r = 0; r < 16; ++r) { oA0[r] = 0.f; oA1[r] = 0.f; oB0[r] = 0.f; oB1[r] = 0.f; }
            run_branch2<true>(oA0, oA1, lsA, qA, oB0, oB1, lsB, qB, kb_, vb_, P0 & 3, 2, S >> 2, (P0 >> 2) - 64, kn, vn, vimg, lane);
            { const int P0c = pc + wave;
              QLD(qA, h, seq_row + P0c + 16 * qi); pre_kv(kn, vn, kb_, vb_, (P0c >> 4) - 64, S >> 4, P0c & 15, 4, lane); }
            lsA += __shfl_xor(lsA, 32); lsB += __shfl_xor(lsB, 32);
            const int lrowA = P0 - pc + 4 * qi, lrowB = lrowA + 128;
            lsA += L1[lrowA]; lsB += L1[lrowB];
            LAS char* prowA = O1 + lrowA * O1S + 8 * hi; LAS char* prowB = prowA + 128 * O1S;
#pragma unroll
            for (int cc = 0; cc < 4; ++cc) {
                u32x2 r0 = *(const LAS u32x2*)(prowA + 16 * cc), r1 = *(const LAS u32x2*)(prowA + 64 + 16 * cc);
                u32x2 w0, w1;
                w0.x = cvtpk(oA0[4 * cc] + bflo(r0.x), oA0[4 * cc + 1] + bfhi(r0.x)); w0.y = cvtpk(oA0[4 * cc + 2] + bflo(r0.y), oA0[4 * cc + 3] + bfhi(r0.y));
                w1.x = cvtpk(oA1[4 * cc] + bflo(r1.x), oA1[4 * cc + 1] + bfhi(r1.x)); w1.y = cvtpk(oA1[4 * cc + 2] + bflo(r1.y), oA1[4 * cc + 3] + bfhi(r1.y));
                *(LAS u32x2*)(prowA + 16 * cc) = w0; *(LAS u32x2*)(prowA + 64 + 16 * cc) = w1;
                r0 = *(const LAS u32x2*)(prowB + 16 * cc); r1 = *(const LAS u32x2*)(prowB + 64 + 16 * cc);
                w0.x = cvtpk(oB0[4 * cc] + bflo(r0.x), oB0[4 * cc + 1] + bfhi(r0.x)); w0.y = cvtpk(oB0[4 * cc + 2] + bflo(r0.y), oB0[4 * cc + 3] + bfhi(r0.y));
                w1.x = cvtpk(oB1[4 * cc] + bflo(r1.x), oB1[4 * cc + 1] + bfhi(r1.x)); w1.y = cvtpk(oB1[4 * cc + 2] + bflo(r1.y), oB1[4 * cc + 3] + bfhi(r1.y));
                *(LAS u32x2*)(prowB + 16 * cc) = w0; *(LAS u32x2*)(prowB + 64 + 16 * cc) = w1;
            }
            if (hi == 0) { L1[lrowA] = lsA; L1[lrowB] = lsB; }
        }
        __syncthreads();
#define FINALIZE_ITEM(r_, P0_) do { lsum += __shfl_xor(lsum, 32); const int lrow = (r_) + 16 * qi; lsum += L1[lrow]; const LAS char* prow = O1 + lrow * O1S + 8 * hi; \
            _Pragma("unroll") for (int c = 0; c < 4; ++c) { const u32x2 w0 = *(const LAS u32x2*)(prow + 16 * c), w1 = *(const LAS u32x2*)(prow + 64 + 16 * c); \
                o0[4 * c] += bflo(w0.x); o0[4 * c + 1] += bfhi(w0.x); o0[4 * c + 2] += bflo(w0.y); o0[4 * c + 3] += bfhi(w0.y); \
                o1[4 * c] += bflo(w1.x); o1[4 * c + 1] += bfhi(w1.x); o1[4 * c + 2] += bflo(w1.y); o1[4 * c + 3] += bfhi(w1.y); } \
            store_out(o0, o1, 1.0f / lsum, AO + (size_t)(seq_row + (P0_)) * 1024 + h * 64, (size_t)16 * 1024, vimg, lane); } while (0)
        {
            const int P0 = pc + wave;
            f32x16 o0, o1; float lsum = 0.f;
#pragma unroll
            for (int rr = 0; rr < 16; ++rr) { o0[rr] = 0.f; o1[rr] = 0.f; }
            run_branch1(o0, o1, lsum, qA, kb_, vb_, P0 & 15, 4, S >> 4, (P0 >> 4) - 64, kn, vn, vimg, lane);
            { const int P0d = pc + wave + 8;
              QLD(qB, h, seq_row + P0d + 16 * qi); pre_kv(kn, vn, kb_, vb_, (P0d >> 4) - 64, S >> 4, P0d & 15, 4, lane); }
            FINALIZE_ITEM(wave, P0);
        }
        {
            const int P0 = pc + wave + 8;
            f32x16 o0, o1; float lsum = 0.f;
#pragma unroll
            for (int rr = 0; rr < 16; ++rr) { o0[rr] = 0.f; o1[rr] = 0.f; }
            run_branch1(o0, o1, lsum, qB, kb_, vb_, P0 & 15, 4, S >> 4, (P0 >> 4) - 64, kn, vn, vimg, lane);
            if (u + G < N_UNITS_A) { UNIT_PARAMS(u + G, hn, Sn, srn, pcn, kbn, vbn); const int P0n = pcn + 64 * wave;
                QLD(qA, hn, srn + P0n + qi); QLD(qB, hn, srn + P0n + 32 + qi); pre_kv(kn, vn, kbn, vbn, P0n - 64, Sn, 0, 0, lane); }
            FINALIZE_ITEM(wave + 8, P0);
        }
#undef FINALIZE_ITEM
        __syncthreads();
    }
#undef QLD
#undef UNIT_PARAMS
    }
    {
        constexpr int KVB = 2 * VIMG_BYTES;
        constexpr int N_UNITS_B = 2 * (M / 64), UPW = 12;
        static_assert(10 * KVB + NWAVES * VIMG_BYTES <= LDS_BYTES, "mixer B LDS map");
        const int tid = wave * 64 + lane, chunk = tid & 7, r0 = tid >> 3;
        LAS char* kvw = (LAS char*)lds + (r0 >> 5) * KVB + (r0 & 31) * VS + chunk * 16;
        const int tile = wave >> 2, hq = wave & 3;
        const LAS char* krd = (const LAS char*)lds + (lane & 31) * VS + hi * 16;
        const LAS char* vrd = (const LAS char*)lds + VIMG_BYTES + (4 * hi + ((lane & 15) >> 2)) * VS + ((lane >> 4) & 1) * 32 + (lane & 3) * 8;
        u32x4 rk[5], rv[5]; bf16x8 qn[4];
        auto unit_ptrs = [&](int u, int& g, int& p0, int& S, int& seq_row) { g = u / (M / 64); const int row0 = (u % (M / 64)) * 64; S = row0 < ROWS_P ? SEQ_P : SEQ_S; seq_row = row0 & ~(S - 1); p0 = row0 - seq_row; };
        const int u_begin = (G == 256) ? vcu * UPW : vcu, u_step = (G == 256) ? 1 : G, u_count = (G == 256) ? UPW : (N_UNITS_B - vcu + G - 1) / G;
#define MB_LOAD(u) do { int g_, p0_, S_, sr_; unit_ptrs((u), g_, p0_, S_, sr_); const bf16* kb2 = QKV + (32 + g_) * HS + rofs(sr_) + chunk * 8; \
        { const bf16* qp_ = QKV + (24 + 4 * g_ + hq) * HS + rofs(sr_ + p0_ + 32 * tile + qi) + 8 * hi; _Pragma("unroll") for (int s = 0; s < 4; ++s) qn[s] = *(const bf16x8*)(qp_ + 16 * s); } \
        _Pragma("unroll") for (int j = 0; j < 5; ++j) { int l = p0_ - 128 + r0 + 64 * j; l = l < 0 ? 0 : (l > S_ - 1 ? S_ - 1 : l); \
            rk[j] = *(const u32x4*)(kb2 + rofs(l)); rv[j] = *(const u32x4*)(kb2 + 2 * HS + rofs(l)); } } while (0)
        for (int rep = 0; rep < ATT_REP_B; ++rep) {
        if (u_count > 0) MB_LOAD(u_begin);
#pragma unroll 1
        for (int ui = 0; ui < u_count; ++ui) {
            const int u = u_begin + ui * u_step;
            int g, p0, S, seq_row; unit_ptrs(u, g, p0, S, seq_row);
#pragma unroll
            for (int j = 0; j < 5; ++j) { *(LAS u32x4*)(kvw + 2 * j * KVB) = rk[j]; *(LAS u32x4*)(kvw + 2 * j * KVB + VIMG_BYTES) = rv[j]; }
            __syncthreads();
            bf16x8 qf[4];
#pragma unroll
            for (int s = 0; s < 4; ++s) qf[s] = qn[s];
            if (ui + 1 < u_count) MB_LOAD(u + u_step);
            const int hb = 4 * g + hq, P0 = p0 + 32 * tile;
            const size_t qrow = (size_t)(seq_row + P0 + qi);
            f32x16 o0, o1; float lsum = (hi == 0) ? __builtin_amdgcn_exp2f(sink[hb] * 1.4426950408889634f) : 0.f;
#pragma unroll
            for (int r = 0; r < 16; ++r) { o0[r] = 0.f; o1[r] = 0.f; }
            const int lstart = P0 - 128;
            const int b_lo = (lstart < -31) ? ((-lstart) >> 5) : 0;
            int b_hi = (S - lstart + 31) >> 5; if (b_hi > 9) b_hi = 9;
            const int tq = qi - 4 * hi;
#define MB_QK(b, scv, vfv) do { \
                const LAS char* kp = krd + ((b) + tile) * KVB; \
                bf16x8 kf[4]; \
                _Pragma("unroll") for (int s = 0; s < 4; ++s) kf[s] = *(const LAS bf16x8*)(kp + 32 * s); \
                scv = qk(kf, qf); \
                const LAS char* vr = vrd + ((b) + tile) * KVB; \
                vfv[0] = ATT_VF(0, 0); vfv[1] = ATT_VF(0, 1); vfv[2] = ATT_VF(1, 0); vfv[3] = ATT_VF(1, 1); } while (0)
#define MB_FIN(b, scv, vfv) do { \
                const int l0 = lstart + 32 * (b); \
                const bool safe_ = ((b) >= 1) && ((b) <= 7) && (l0 >= 0) && (l0 + 31 < S); \
                if (!safe_) { \
                    const int tb = 32 * (b) - tq, lb = l0 + 4 * hi; \
                    _Pragma("unroll") for (int r = 0; r < 16; ++r) { \
                        const int cr = (r & 3) + 8 * (r >> 2); \
                        const bool ok = ((unsigned)(tb + cr) <= 256u) && ((unsigned)(lb + cr) < (unsigned)S); \
                        scv[r] = ok ? scv[r] : -INFINITY; } } \
                float p[16]; \
                _Pragma("unroll") for (int r = 0; r < 16; ++r) { p[r] = __builtin_amdgcn_exp2f(scv[r]); lsum += p[r]; } \
                u32x4 pw0, pw1; \
                pw0.x = cvtpk(p[0], p[1]); pw0.y = cvtpk(p[2], p[3]); pw0.z = cvtpk(p[4], p[5]); pw0.w = cvtpk(p[6], p[7]); \
                pw1.x = cvtpk(p[8], p[9]); pw1.y = cvtpk(p[10], p[11]); pw1.z = cvtpk(p[12], p[13]); pw1.w = cvtpk(p[14], p[15]); \
                const bf16x8 pf0 = __builtin_bit_cast(bf16x8, pw0), pf1 = __builtin_bit_cast(bf16x8, pw1); \
                o0 = __builtin_amdgcn_mfma_f32_32x32x16_bf16(vfv[0], pf0, o0, 0, 0, 0); \
                o1 = __builtin_amdgcn_mfma_f32_32x32x16_bf16(vfv[1], pf0, o1, 0, 0, 0); \
                o0 = __builtin_amdgcn_mfma_f32_32x32x16_bf16(vfv[2], pf1, o0, 0, 0, 0); \
                o1 = __builtin_amdgcn_mfma_f32_32x32x16_bf16(vfv[3], pf1, o1, 0, 0, 0); } while (0)
#define ATT_VF(t, d0) __builtin_shufflevector(vtr(vr + (16 * (t)) * VS + 64 * (d0)), vtr(vr + (16 * (t) + 8) * VS + 64 * (d0)), 0, 1, 2, 3, 4, 5, 6, 7)
            {
                f32x16 scA, scB; bf16x8 vfA[4], vfB[4];
                int b = b_lo;
                MB_QK(b, scA, vfA);
#pragma unroll 1
                for (; b + 1 < b_hi; b += 2) {
                    MB_QK(b + 1, scB, vfB);
                    MB_FIN(b, scA, vfA);
                    if (b + 2 < b_hi) MB_QK(b + 2, scA, vfA);
                    MB_FIN(b + 1, scB, vfB);
                }
                if (b < b_hi) MB_FIN(b, scA, vfA);
            }
#undef ATT_VF
#undef MB_QK
#undef MB_FIN
            lsum += __shfl_xor(lsum, 32);
            store_out(o0, o1, 1.0f / lsum, AO + (size_t)(seq_row + P0) * 1024 + 512 + hb * 64, (size_t)1024, (LAS char*)lds + 10 * KVB + wave * VIMG_BYTES, lane);
            __syncthreads();
        }
        }
#undef MB_LOAD
    }
}
}

#define XB_TMO      128
#define XB_XCNT(j)  (256  + 64 * (j))
#define XB_XSUB(j)  (1280 + 64 * (j))
#define XB_XGEN(j)  (2304 + 64 * (j))
#define XB_TOP      3328
#define XB_TOPGEN   3392
#define XCD_BAR_WORDS 3456
#define XB_SPIN_CAP (1u << 18)

__device__ __forceinline__ unsigned xb_ld(unsigned* p)              { return __hip_atomic_load(p, __ATOMIC_RELAXED, __HIP_MEMORY_SCOPE_AGENT); }
__device__ __forceinline__ unsigned xb_add(unsigned* p, unsigned v) { return __hip_atomic_fetch_add(p, v, __ATOMIC_RELAXED, __HIP_MEMORY_SCOPE_AGENT); }
__device__ __forceinline__ unsigned xb_xcc_id() { return (unsigned)__builtin_amdgcn_s_getreg((3 << 11) | 20) & 0xFu; }
#define XB_SPIN(cond, bar) do { unsigned _sp = 0; while (cond) { __builtin_amdgcn_s_sleep(1); \
    if ((++_sp & 255u) == 0u) { if (xb_ld(&(bar)[XB_TMO])) break; if (_sp > XB_SPIN_CAP) { atomicAdd(&(bar)[XB_TMO], 1u); break; } } } } while (0)

struct XcdBarrier {
    unsigned* bar; unsigned x;
    volatile LAS unsigned* st;
};

__device__ __forceinline__ XcdBarrier xcd_barrier_post(unsigned* bar, volatile LAS unsigned* st) {
    XcdBarrier b; b.bar = bar; b.x = xb_xcc_id(); b.st = st;
    if (threadIdx.x == 0) (void)xb_add(&bar[XB_XCNT(b.x)], 1u);
    return b;
}
__device__ __forceinline__ void xcd_barrier_complete(unsigned* bar, unsigned x, unsigned& nloc, unsigned& nx) {
    const unsigned G = gridDim.x * gridDim.y * gridDim.z;
    unsigned sum, cnt, mine, sp = 0u;
    for (;;) {
        sum = 0u; cnt = 0u; mine = 0u;
#pragma unroll
        for (unsigned j = 0; j < 16; ++j) { const unsigned c = xb_ld(&bar[XB_XCNT(j)]); sum += c; cnt += (c > 0u) ? 1u : 0u; mine = (j == x) ? c : mine; }
        if (sum == G) break;
        __builtin_amdgcn_s_sleep(1);
        if ((++sp & 255u) == 0u) { if (xb_ld(&bar[XB_TMO])) break; if (sp > XB_SPIN_CAP) { atomicAdd(&bar[XB_TMO], 1u); break; } }
    }
    nloc = mine > 0u ? mine : 1u; nx = cnt > 0u ? cnt : 1u;
}

__device__ __forceinline__ void xcd_barrier(const XcdBarrier& b) {
    asm volatile("s_waitcnt vmcnt(0)" ::: "memory");
    __syncthreads();
    if (threadIdx.x == 0) {
        unsigned* bar = b.bar;
        __builtin_amdgcn_s_waitcnt(0);
        unsigned nloc = b.st[0], nx = b.st[1];
        if (nloc == 0u) { xcd_barrier_complete(bar, b.x, nloc, nx); b.st[0] = nloc; b.st[1] = nx; }
        const unsigned old = xb_add(&bar[XB_XSUB(b.x)], 1u);
        const unsigned gen = old / nloc;
        if (old + 1u == (gen + 1u) * nloc) {
            __builtin_amdgcn_fence(__ATOMIC_RELEASE, "agent");
            asm volatile("s_waitcnt vmcnt(0)" ::: "memory");
            const unsigned og = xb_add(&bar[XB_TOP], 1u);
            const unsigned tg = og / nx;
            if (og + 1u == (tg + 1u) * nx) xb_add(&bar[XB_TOPGEN], 1u);
            else XB_SPIN(xb_ld(&bar[XB_TOPGEN]) == tg, bar);
            __builtin_amdgcn_fence(__ATOMIC_ACQUIRE, "agent");
            xb_add(&bar[XB_XGEN(b.x)], 1u);
            asm volatile("s_waitcnt vmcnt(0)" ::: "memory");
        } else {
            XB_SPIN(xb_ld(&bar[XB_XGEN(b.x)]) == gen, bar);
            __builtin_amdgcn_fence(__ATOMIC_ACQUIRE, "agent");
            asm volatile("s_waitcnt vmcnt(0)" ::: "memory");
        }
    }
    __syncthreads();
}

struct Args { const float* in[14]; float* out; unsigned char* ws; int ph_lo, ph_hi; };
__global__ void __launch_bounds__(NWAVES * 64, 2) hymba_fwd(Args args) {
    extern __shared__ __attribute__((aligned(16))) unsigned char lds_raw[];
    cg::grid_group grid = cg::this_grid();
    LAS unsigned char* lds = (LAS unsigned char*)lds_raw;
    const int tid = threadIdx.x, lane = tid & 63, wave = __builtin_amdgcn_readfirstlane(tid >> 6);
    const int G = gridDim.x, bx = blockIdx.x;
    const int vcu = (G % 8 == 0) ? (bx % 8) * (G / 8) + bx / 8 : bx;
    const int gw = vcu * NWAVES + wave, NGW = G * NWAVES;
    unsigned char* ws = args.ws;
    const float* xp = args.in[0]; const float* xs = args.in[1]; const float* attn_norm = args.in[2]; const float* w_in = args.in[3];
    const float* qnorm_a = args.in[4]; const float* knorm_a = args.in[5]; const float* qnorm_b = args.in[6]; const float* knorm_b = args.in[7];
    const float* sink_b = args.in[8]; const float* w_out = args.in[9]; const float* ffn_norm = args.in[10]; const float* w_gate = args.in[11];
    const float* w_up = args.in[12]; const float* w_down = args.in[13];
    float* rowss = (float*)(ws + WS_ROWSS); float* cosT = (float*)(ws + WS_COS); float* sinT = (float*)(ws + WS_SIN);
    bf16* Win_t = (bf16*)(ws + WS_WIN); bf16* Wout_t = (bf16*)(ws + WS_WOUT); bf16* Wgu_t = (bf16*)(ws + WS_WGU); bf16* Wdn_t = (bf16*)(ws + WS_WDN);
    bf16* XN = (bf16*)(ws + WS_XN); bf16* AO = XN; bf16* QKV = (bf16*)(ws + WS_QKV); bf16* HB = (bf16*)(ws + WS_H); bf16* XB = (bf16*)(ws + WS_XB);
    const int lo = args.ph_lo, hi = args.ph_hi;
    volatile LAS unsigned* bst = (volatile LAS unsigned*)(lds + LDS_BYTES - 64);
    if (tid < 16) ((LAS unsigned*)(lds + LDS_BYTES - 64))[tid] = 0u;
    __syncthreads();
    XcdBarrier xbar = xcd_barrier_post((unsigned*)(ws + WS_BAR), bst);
    if (lo < 0) grid.sync();
#define IN(k) (lo <= (k) && (k) < hi)
#define SEAM(k) do { if (IN(k) && IN((k) + 1)) xcd_barrier(xbar); } while (0)

    if (IN(0)) {
        LAS float* scr = (LAS float*)(lds + wave * 16384);
        constexpr int I_IN = 16 * 72, I_OUT = 16 * 32, I_G = 16 * 88, I_D = 44 * 32, NITEMS = I_IN + I_OUT + 2 * I_G + I_D;
        for (int it = gw; it < NITEMS; it += NGW) {
            int r = it;
            if (r < I_IN) { const int kb = r / 72, nb = r % 72, n0 = nb * 32; const int dst = 256 * (n0 >> 8) + 128 * ((n0 & 63) >> 5) + 32 * ((n0 & 255) >> 6);
                p0_transpose_item(w_in, D, NIN, Win_t, dst, nullptr, scr, kb, nb, lane); continue; } r -= I_IN;
            if (r < I_OUT) { const int kb = r / 32, nb = r % 32; p0_transpose_item(w_out, D, D, Wout_t, nb * 32, nullptr, scr, kb, nb, lane); continue; } r -= I_OUT;
            if (r < I_G) { const int kb = r / 88, nb = r % 88, n0 = nb * 32; p0_transpose_item(w_gate, D, DFF, Wgu_t, 256 * (n0 >> 7) + (n0 & 127), ffn_norm, scr, kb, nb, lane); continue; } r -= I_G;
            if (r < I_G) { const int kb = r / 88, nb = r % 88, n0 = nb * 32; p0_transpose_item(w_up, D, DFF, Wgu_t, 256 * (n0 >> 7) + 128 + (n0 & 127), ffn_norm, scr, kb, nb, lane); continue; } r -= I_G;
            { const int kb = r / 32, nb = r % 32; p0_transpose_item(w_down, DFF, D, Wdn_t, nb * 32, nullptr, scr, kb, nb, lane); }
        }
        const int gt = gw * 64 + lane, NGT = NGW * 64;
        for (int i = gt; i < SEQ_P * 32; i += NGT) { float c, s; rope_entry(i >> 5, i & 31, c, s); cosT[i] = c; sinT[i] = s; }
        for (int i = gt; i < M; i += NGT) rowss[i] = 0.f;
        for (int m0 = gw; m0 < M; m0 += 4 * NGW) {
            f32x4 v[4][4]; float ssq[4];
#pragma unroll
            for (int q = 0; q < 4; ++q) { const int m = m0 + q * NGW; const int mm = m < M ? m : M - 1;
                const float* xrow = mm < ROWS_P ? xp + (size_t)mm * D : xs + (size_t)(mm - ROWS_P) * D;
                const f32x4* xr = (const f32x4*)xrow + lane;
#pragma unroll
                for (int j = 0; j < 4; ++j) v[q][j] = xr[64 * j]; }
            const f32x4* gr = (const f32x4*)attn_norm + lane;
#pragma unroll
            for (int q = 0; q < 4; ++q) { float s = 0.f;
#pragma unroll
                for (int j = 0; j < 4; ++j) s += (v[q][j].x * v[q][j].x + v[q][j].y * v[q][j].y) + (v[q][j].z * v[q][j].z + v[q][j].w * v[q][j].w);
                ssq[q] = s; }
#pragma unroll
            for (int q = 0; q < 4; ++q) { const int m = m0 + q * NGW; if (m >= M) continue;
                const float rstd = 1.f / sqrtf(wave_sum(ssq[q]) * (1.f / D) + 1e-6f);
                unsigned long long* o8 = (unsigned long long*)(XN + (size_t)m * D) + lane;
#pragma unroll
                for (int j = 0; j < 4; ++j) { const f32x4 g = gr[64 * j]; o8[64 * j] = (unsigned long long)pk2(v[q][j].x * rstd * g.x, v[q][j].y * rstd * g.y) | ((unsigned long long)pk2(v[q][j].z * rstd * g.z, v[q][j].w * rstd * g.w) << 32); } }
        }
        __syncthreads();
    }
    SEAM(0);
    if (IN(1)) {
        pg8::Gemm g{XN, Win_t, M, NIN, D}; pg8::StaticOrder S; S.init(M, NIN, G, bx);
        pg8::EpiQKV E{QKV, cosT, sinT, qnorm_a, knorm_a, qnorm_b, knorm_b};
        pg8::gemm_phase<pg8::EpiQKV, pg8::StaticOrder, PG8_ALIGN, PG8_SP2>(lds, g, S, E);
    }
    SEAM(1);
    if (IN(2)) att::attention_phase(QKV, AO, sink_b, lds, vcu, G, wave, lane);
    SEAM(2);
    if (IN(3)) {
        pg8::Gemm g{AO, Wout_t, M, D, D}; pg8::StaticOrder S; S.init(M, D, G, bx);
        pg8::EpiOut E{xp, xs, XB, rowss};
        pg8::gemm_phase<pg8::EpiOut, pg8::StaticOrder, PG8_ALIGN, PG8_SP2>(lds, g, S, E);
    }
    SEAM(3);
    if (IN(4)) {
        pg8::Gemm g{XB, Wgu_t, M, NGU, D}; pg8::StaticOrder S; S.init(M, NGU, G, bx);
        pg8::EpiGU E{HB, rowss};
        pg8::gemm_phase<pg8::EpiGU, pg8::StaticOrder, PG8_ALIGN, PG8_SP2>(lds, g, S, E);
    }
    SEAM(4);
    if (IN(5)) {
        pg8::Gemm g{HB, Wdn_t, M, D, DFF}; pg8::StaticOrder S; S.init(M, D, G, bx);
        pg8::EpiDown E{args.out, XB};
        pg8::gemm_phase<pg8::EpiDown, pg8::StaticOrder, PG8_ALIGN, PG8_SP2>(lds, g, S, E);
    }
#undef IN
#undef SEAM
}

#ifndef MK_N_LAUNCHES
#define MK_N_LAUNCHES 1
#endif
extern "C" void kernel_launch(void* const* d_in, const int* in_sizes, int n_in, void* d_out, int out_size, void* d_ws, size_t ws_size, hipStream_t stream) {
    static int grid = 0;
    if (grid == 0) {
        if (n_in != 14 || out_size != M * D || ws_size < WS_END) { fprintf(stderr, "kernel_launch: unexpected shapes (n_in %d, out %d, ws %zu); nothing launched\n", n_in, out_size, ws_size); grid = -1; return; }
        int dev = 0, cus = 0, per_cu = 0;
        if (hipGetDevice(&dev) != hipSuccess || hipDeviceGetAttribute(&cus, hipDeviceAttributeMultiprocessorCount, dev) != hipSuccess) { grid = -1; return; }
        if (hipFuncSetAttribute((const void*)hymba_fwd, hipFuncAttributeMaxDynamicSharedMemorySize, LDS_BYTES) != hipSuccess) { fprintf(stderr, "kernel_launch: hipFuncSetAttribute failed\n"); grid = -1; return; }
        if (hipOccupancyMaxActiveBlocksPerMultiprocessor(&per_cu, (const void*)hymba_fwd, NWAVES * 64, LDS_BYTES) != hipSuccess || per_cu < 1) { fprintf(stderr, "kernel_launch: occupancy query says %d\n", per_cu); per_cu = 1; }
        (void)hipGetLastError();
        grid = cus * 1;
    }
    if (grid < 0) return;
    if (hipMemsetAsync((char*)d_ws + WS_BAR, 0, WS_BAR_BYTES, stream) != hipSuccess) { fprintf(stderr, "kernel_launch: hipMemsetAsync of the barrier words failed; nothing launched\n"); return; }
    Args a{};
    for (int i = 0; i < 14; ++i) a.in[i] = (const float*)d_in[i];
    a.out = (float*)d_out; a.ws = (unsigned char*)d_ws;
    for (int li = 0; li < MK_N_LAUNCHES; ++li) {
        if (MK_N_LAUNCHES == 1) { a.ph_lo = 0; a.ph_hi = 6; } else { a.ph_lo = li; a.ph_hi = li + 1; }
        void* kargs[] = {&a};
        const hipError_t e = hipLaunchCooperativeKernel((const void*)hymba_fwd, dim3(grid), dim3(NWAVES * 64), kargs, LDS_BYTES, stream);
        if (e != hipSuccess) { fprintf(stderr, "kernel_launch: cooperative launch %d failed: %s (grid %d)\n", li, hipGetErrorString(e), grid); break; }
    }
}
```

```cpp
#include <hip/hip_runtime.h>
#include <hip/hip_cooperative_groups.h>
#include <cstdio>
#include <cstdint>
namespace cg = cooperative_groups;
namespace pg8 {
#define PG8_LAS __attribute__((address_space(3)))
typedef unsigned short bf16_t;
typedef short bf16x8 __attribute__((ext_vector_type(8)));
typedef float f32x4 __attribute__((ext_vector_type(4)));
typedef unsigned u32x4 __attribute__((ext_vector_type(4)));
constexpr int BM = 256, BK = 64, HALF = 128, HTB = HALF * BK * 2  , STAGE_BYTES = 8 * HTB, NXCD = 8, WGM = 8;

__host__ __device__ __forceinline__ int lds_byte(int r, int c) { const int st = (r >> 4) * 2 + (c >> 5), rr = r & 15, cc = c & 31, ob = rr * 64 + cc * 2; return st * 1024 + (ob ^ (((ob >> 9) & 1) << 5)); }
__host__ __device__ __forceinline__ void stage_rc(int b, int& R, int& C) { const int st = b / 1024, sb = b % 1024, swz = sb ^ (((sb >> 9) & 1) << 5); R = (st >> 1) * 16 + swz / 64; C = (st & 1) * 32 + (swz % 64) / 2; }
__host__ __device__ __forceinline__ int perm32(int rho) { const int n = rho >> 4, i = rho & 15; return 8 * (i >> 2) + 4 * n + (i & 3); }

struct Unit { int pm, pn; };
struct Gemm { const bf16_t* A; const bf16_t* Bt; int M, N, K; };

struct StaticOrder {
    int nM, nN, nwg, G, c;
    __host__ __device__ void init(int M, int N, int G_, int c_) { nM = M / BM; nN = N / BM; nwg = nM * nN; G = G_; c = c_; }
    __host__ __device__ bool next(int i, Unit& u) const {
        const long L = (long)i * G + c; if (L >= nwg) return false;
        int wgid = (int)L; { const int q = nwg / NXCD, r = nwg % NXCD, xcd = wgid % NXCD, off = wgid / NXCD; wgid = (xcd < r ? xcd * (q + 1) : r * (q + 1) + (xcd - r) * q) + off; }
        const int nig = WGM * nN, gid = wgid / nig, fm = gid * WGM, gsz = (nM - fm) < WGM ? (nM - fm) : WGM;
        u.pm = fm + ((wgid % nig) % gsz); u.pn = (wgid % nig) / gsz; return true;
    }
    __device__ __forceinline__ void a_ready(const Unit&) const {}
    __device__ __forceinline__ void done(const Unit&) const {}
};

typedef float f32x2 __attribute__((ext_vector_type(2)));
typedef __bf16 bf16x2v __attribute__((ext_vector_type(2)));
__device__ __forceinline__ unsigned cvt_pk_bf16(float lo, float hi) { f32x2 v = {lo, hi}; bf16x2v b = __builtin_convertvector(v, bf16x2v); return __builtin_bit_cast(unsigned, b); }
template <class Epi, class Sched, bool ALIGN_EPI = false, bool SP2 = false>
__device__ __forceinline__ void gemm_phase(PG8_LAS unsigned char* lds, const Gemm g, const Sched& S, const Epi& E) {
    const int tid = threadIdx.x, wid = __builtin_amdgcn_readfirstlane(tid >> 6), lane = tid & 63, wr = wid >> 2, wc = wid & 3, fr = lane & 15, fq = lane >> 4;
    const int K = g.K, nt = K / BK;
    unsigned voffA[2], voffB[2];
#pragma unroll
    for (int i = 0; i < 2; ++i) { int R, C; stage_rc(tid * 16 + i * 8192, R, C); const int Rb = Epi::PERM ? ((R & ~31) + perm32(R & 31)) : R;
        voffA[i] = (unsigned)(R * K + C) * 2u; voffB[i] = (unsigned)(Rb * K + C) * 2u; }
    const size_t kstep = (size_t)(BK * 2);
    const size_t hstep = (size_t)HALF * K * 2;
    const size_t tstep = 2 * hstep;
    const unsigned ldsw = (unsigned)wid * 1024u;
    const int aoff = lds_byte(wr * 64 + fr, fq * 8), boff = lds_byte(wc * 32 + fr, fq * 8);
#define PG8_SA(b, h) (((b) * 2 + (h)) * HTB)
#define PG8_SB(b, h) ((4 + (b) * 2 + (h)) * HTB)
#define PG8_STAGE(bufoff, gbase, voff) do { _Pragma("unroll") for (int _i = 0; _i < 2; ++_i) \
        __builtin_amdgcn_global_load_lds((const unsigned*)((const char*)(gbase) + (voff)[_i]), (PG8_LAS unsigned*)(lds + (bufoff) + ldsw + _i * 8192), 16, 0, 0); } while (0)
#define PG8_LDA(dst, b, h) do { _Pragma("unroll") for (int m = 0; m < 4; ++m) _Pragma("unroll") for (int k = 0; k < 2; ++k) dst[m][k] = *(const PG8_LAS bf16x8*)(lds + PG8_SA(b, h) + aoff + m * 2048 + k * 1024); } while (0)
#define PG8_LDB(dst, b, h) do { _Pragma("unroll") for (int n = 0; n < 2; ++n) _Pragma("unroll") for (int k = 0; k < 2; ++k) dst[n][k] = *(const PG8_LAS bf16x8*)(lds + PG8_SB(b, h) + boff + n * 2048 + k * 1024); } while (0)
#define PG8_MMA(ai, bj, At, Bt) do { __builtin_amdgcn_s_setprio(1); _Pragma("unroll") for (int m = 0; m < 4; ++m) _Pragma("unroll") for (int n = 0; n < 2; ++n) _Pragma("unroll") for (int k = 0; k < 2; ++k) \
        acc[ai][bj][m][n] = __builtin_amdgcn_mfma_f32_16x16x32_bf16(Bt[n][k], At[m][k], acc[ai][bj][m][n], 0, 0, 0); __builtin_amdgcn_s_setprio(0); } while (0)
#define PG8_WAIT_V(n) asm volatile("s_waitcnt vmcnt(" #n ")" ::: "memory")
#define PG8_WAIT_L(n) asm volatile("s_waitcnt lgkmcnt(" #n ")" ::: "memory")
#define PG8_BAR __builtin_amdgcn_s_barrier()
#define PG8_SCHED __builtin_amdgcn_sched_barrier(0)
    Unit cur, nxt; int ui = 0;
    if (!S.next(0, cur)) return;
    f32x4 acc[2][2][4][2];
#pragma unroll
    for (int a = 0; a < 2; ++a)
#pragma unroll
        for (int b = 0; b < 2; ++b)
#pragma unroll
            for (int m = 0; m < 4; ++m)
#pragma unroll
                for (int n = 0; n < 2; ++n) acc[a][b][m][n] = (f32x4){0.f, 0.f, 0.f, 0.f};
    bf16x8 At[4][2], B0[2][2], B1[2][2];
    const char* cA = (const char*)g.A + (size_t)cur.pm * tstep; const char* cB = (const char*)g.Bt + (size_t)cur.pn * tstep;
    S.a_ready(cur);
    if constexpr (SP2) {
        PG8_STAGE(PG8_SB(0, 0), cB, voffB); PG8_STAGE(PG8_SB(0, 1), cB + hstep, voffB); PG8_STAGE(PG8_SA(0, 0), cA, voffA); PG8_STAGE(PG8_SA(0, 1), cA + hstep, voffA);
        if (wr == 1) PG8_BAR;
        PG8_WAIT_V(2); PG8_BAR;
        PG8_STAGE(PG8_SB(1, 0), cB + kstep, voffB); PG8_STAGE(PG8_SA(1, 0), cA + kstep, voffA); PG8_STAGE(PG8_SB(1, 1), cB + hstep + kstep, voffB);
        PG8_WAIT_V(6); PG8_BAR;
    } else {
        PG8_STAGE(PG8_SB(0, 0), cB, voffB); PG8_STAGE(PG8_SA(0, 0), cA, voffA); PG8_STAGE(PG8_SB(0, 1), cB + hstep, voffB); PG8_STAGE(PG8_SA(0, 1), cA + hstep, voffA);
        if (wr == 1) PG8_BAR;
        PG8_WAIT_V(4); PG8_BAR;
        PG8_STAGE(PG8_SB(1, 0), cB + kstep, voffB); PG8_STAGE(PG8_SA(1, 0), cA + kstep, voffA); PG8_STAGE(PG8_SB(1, 1), cB + hstep + kstep, voffB);
        PG8_WAIT_V(6); PG8_BAR;
    }
    for (;;) {
        const bool has_next = S.next(ui + 1, nxt);
        const char* nA = has_next ? (const char*)g.A + (size_t)nxt.pm * tstep : cA; const char* nB = has_next ? (const char*)g.Bt + (size_t)nxt.pn * tstep : cB;
        for (int t = 0; t < nt; t += 2) {
            const bool last = (t == nt - 2);
            const char* a1 = cA + (size_t)(t + 1) * kstep;
            const char* a2 = last ? nA : cA + (size_t)(t + 2) * kstep; const char* b2 = last ? nB : cB + (size_t)(t + 2) * kstep;
            const char* a3 = a2 + kstep; const char* b3 = b2 + kstep;
            if (last && has_next) S.a_ready(nxt);
            if constexpr (SP2) {
            PG8_LDB(B0, 0, 0); PG8_LDB(B1, 0, 1); PG8_SCHED; PG8_LDA(At, 0, 0); PG8_STAGE(PG8_SA(1, 1), a1 + hstep, voffA);
            PG8_WAIT_V(8); PG8_WAIT_L(0); PG8_BAR; PG8_MMA(0, 0, At, B0); PG8_MMA(0, 1, At, B1); PG8_BAR; PG8_SCHED;
            PG8_LDA(At, 0, 1); PG8_STAGE(PG8_SB(0, 0), b2, voffB); PG8_STAGE(PG8_SB(0, 1), b2 + hstep, voffB); PG8_STAGE(PG8_SA(0, 0), a2, voffA);
            PG8_WAIT_V(8); PG8_WAIT_L(0); PG8_BAR; PG8_MMA(1, 0, At, B0); PG8_MMA(1, 1, At, B1); PG8_BAR; PG8_SCHED;
            PG8_LDB(B0, 1, 0); PG8_LDB(B1, 1, 1); PG8_SCHED; PG8_LDA(At, 1, 0); PG8_STAGE(PG8_SA(0, 1), a2 + hstep, voffA);
            PG8_WAIT_V(8); PG8_WAIT_L(0); PG8_BAR; PG8_MMA(0, 0, At, B0); PG8_MMA(0, 1, At, B1); PG8_BAR; PG8_SCHED;
            PG8_LDA(At, 1, 1); PG8_STAGE(PG8_SB(1, 0), b3, voffB); PG8_STAGE(PG8_SB(1, 1), b3 + hstep, voffB); PG8_STAGE(PG8_SA(1, 0), a3, voffA);
            PG8_WAIT_V(8); PG8_WAIT_L(0); PG8_BAR; PG8_MMA(1, 0, At, B0); PG8_MMA(1, 1, At, B1); PG8_BAR; PG8_SCHED;
            } else {
            PG8_LDB(B0, 0, 0); PG8_SCHED; PG8_LDA(At, 0, 0); PG8_STAGE(PG8_SA(1, 1), a1 + hstep, voffA);
            PG8_WAIT_L(8); PG8_BAR; PG8_WAIT_L(0); PG8_MMA(0, 0, At, B0); PG8_BAR; PG8_SCHED;
            PG8_LDB(B1, 0, 1); PG8_STAGE(PG8_SB(0, 0), b2, voffB);
            PG8_BAR; PG8_WAIT_L(0); PG8_MMA(0, 1, At, B1); PG8_BAR;
            PG8_LDA(At, 0, 1); PG8_STAGE(PG8_SA(0, 0), a2, voffA);
            PG8_BAR; PG8_WAIT_L(0); PG8_MMA(1, 0, At, B0); PG8_BAR; PG8_SCHED;
            PG8_STAGE(PG8_SB(0, 1), b2 + hstep, voffB);
            PG8_WAIT_V(6); PG8_BAR; PG8_MMA(1, 1, At, B1); PG8_BAR;
            PG8_LDB(B0, 1, 0); PG8_SCHED; PG8_LDA(At, 1, 0); PG8_STAGE(PG8_SA(0, 1), a2 + hstep, voffA);
            PG8_WAIT_L(8); PG8_BAR; PG8_WAIT_L(0); PG8_MMA(0, 0, At, B0); PG8_BAR; PG8_SCHED;
            PG8_LDB(B1, 1, 1); PG8_STAGE(PG8_SB(1, 0), b3, voffB);
            PG8_BAR; PG8_WAIT_L(0); PG8_MMA(0, 1, At, B1); PG8_BAR;
            PG8_LDA(At, 1, 1); PG8_STAGE(PG8_SA(1, 0), a3, voffA);
            PG8_BAR; PG8_WAIT_L(0); PG8_MMA(1, 0, At, B0); PG8_BAR; PG8_SCHED;
            PG8_STAGE(PG8_SB(1, 1), b3 + hstep, voffB);
            PG8_WAIT_V(6); PG8_BAR; PG8_MMA(1, 1, At, B1); PG8_BAR;
            }
        }
        if constexpr (ALIGN_EPI) { if (wr == 0) PG8_BAR; }
        if constexpr (!Epi::AFTER_DRAIN) { E(acc, cur, wr, wc, fr, fq); S.done(cur); }
        if (!has_next) break;
#pragma unroll
        for (int a = 0; a < 2; ++a)
#pragma unroll
            for (int b = 0; b < 2; ++b)
#pragma unroll
                for (int m = 0; m < 4; ++m)
#pragma unroll
                    for (int n = 0; n < 2; ++n) acc[a][b][m][n] = (f32x4){0.f, 0.f, 0.f, 0.f};
        cur = nxt; cA = nA; cB = nB; ++ui;
        if constexpr (ALIGN_EPI) { if (wr == 1) PG8_BAR; }
    }
    PG8_WAIT_V(0);
    if constexpr (!ALIGN_EPI) { if (wr == 0) PG8_BAR; }
    PG8_BAR;
    if constexpr (Epi::AFTER_DRAIN) { E.fused(acc, cur, wr, wc, fr, fq, lds, wid, lane); S.done(cur); }
#undef PG8_SA
#undef PG8_SB
#undef PG8_STAGE
#undef PG8_LDA
#undef PG8_LDB
#undef PG8_MMA
#undef PG8_WAIT_V
#undef PG8_WAIT_L
#undef PG8_BAR
#undef PG8_SCHED
}
}

namespace pg8 {
constexpr int ROWS_P = 32768, SEQ_P = 16384, SEQ_S = 2048;
constexpr float QSCALE = 0.125f * 1.4426950408889634f;
constexpr float NORM_EPS = 1e-6f;
constexpr size_t HS_QKV = (size_t)(98304 + 98304 / 16) * 64;
__device__ __forceinline__ float dot4(const f32x4 a) { return (a[0] * a[0] + a[1] * a[1]) + (a[2] * a[2] + a[3] * a[3]); }
__device__ __forceinline__ float rows4_sum(float v) {
    const unsigned u = __builtin_bit_cast(unsigned, v);
    auto a = __builtin_amdgcn_permlane16_swap(u, u, false, false);
    const float s16 = __builtin_bit_cast(float, (unsigned)a[0]) + __builtin_bit_cast(float, (unsigned)a[1]);
    const unsigned w = __builtin_bit_cast(unsigned, s16);
    auto b = __builtin_amdgcn_permlane32_swap(w, w, false, false);
    return __builtin_bit_cast(float, (unsigned)b[0]) + __builtin_bit_cast(float, (unsigned)b[1]);
}

struct EpiQKV {
    static constexpr bool PERM = true, AFTER_DRAIN = false;
    bf16_t* O; const float* cosT; const float* sinT; const float* gqa; const float* gka; const float* gqb; const float* gkb;
    __device__ __forceinline__ void operator()(const f32x4 (&acc)[2][2][4][2], const Unit& u, int wr, int wc, int fr, int fq) const {
        const int pn = u.pn;
        const float* g = nullptr; float sc = 1.f;
        if (pn < 2) { g = gqa; sc = QSCALE; } else if (pn < 4) { g = gka; } else if (pn < 6) { } else if (pn < 8) { g = gqb; sc = QSCALE; } else if (wc < 2) { g = gkb; }
        if (g) body<true>(acc, u, wr, wc, fr, fq, g, sc); else body<false>(acc, u, wr, wc, fr, fq, g, sc);
    }
    template <bool ROPE>
    __device__ __forceinline__ void body(const f32x4 (&acc)[2][2][4][2], const Unit& u, int wr, int wc, int fr, int fq, const float* g, float sc) const {
        const int pn = u.pn;
        f32x4 gv[2][2];
#pragma unroll
        for (int bj = 0; bj < 2; ++bj)
#pragma unroll
            for (int n = 0; n < 2; ++n) { if constexpr (ROPE) gv[bj][n] = *(const f32x4*)(g + 32 * bj + 8 * fq + 4 * n); else gv[bj][n] = (f32x4){1.f, 1.f, 1.f, 1.f}; }
        f32x4 tb[1][4];
#define QKV_LDT(k, slot) do { if constexpr (ROPE) { const int row_ = u.pm * BM + ((k) >> 2) * HALF + wr * 64 + ((k) & 3) * 16 + fr; const int pos_ = row_ < ROWS_P ? (row_ & (SEQ_P - 1)) : (row_ & (SEQ_S - 1)); \
            tb[slot][0] = *(const f32x4*)(cosT + pos_ * 32 + 8 * fq); tb[slot][1] = *(const f32x4*)(cosT + pos_ * 32 + 8 * fq + 4); \
            tb[slot][2] = *(const f32x4*)(sinT + pos_ * 32 + 8 * fq); tb[slot][3] = *(const f32x4*)(sinT + pos_ * 32 + 8 * fq + 4); } } while (0)
        QKV_LDT(0, 0);
#pragma unroll
        for (int k = 0; k < 8; ++k) {
            const int ai = k >> 2, m = k & 3;
            const int row = u.pm * BM + ai * HALF + wr * 64 + m * 16 + fr;
            f32x4 v00 = acc[ai][0][m][0], v01 = acc[ai][0][m][1], v10 = acc[ai][1][m][0], v11 = acc[ai][1][m][1];
            if constexpr (ROPE) {
                float ss = (dot4(v00) + dot4(v01)) + (dot4(v10) + dot4(v11));
                ss = rows4_sum(ss);
                const float rinv = __builtin_amdgcn_rsqf(ss * (1.0f / 64.0f) + NORM_EPS);
                const f32x4 c0 = tb[0][0], c1 = tb[0][1], s0 = tb[0][2], s1 = tb[0][3];
                const f32x4 y00 = v00 * rinv * gv[0][0], y01 = v01 * rinv * gv[0][1], y10 = v10 * rinv * gv[1][0], y11 = v11 * rinv * gv[1][1];
                v00 = (y00 * c0 - y10 * s0) * sc; v10 = (y10 * c0 + y00 * s0) * sc;
                v01 = (y01 * c1 - y11 * s1) * sc; v11 = (y11 * c1 + y01 * s1) * sc;
            }
            if (k + 1 < 8) { QKV_LDT(k + 1, 0); }
            if constexpr (ROPE) asm volatile("" ::: "memory");
            bf16_t* rowp = O + (size_t)(pn * 4 + wc) * HS_QKV + (size_t)(row + (row >> 4)) * 64 + fq * 8;
            u32x4 w0, w1;
            w0.x = cvt_pk_bf16(v00[0], v00[1]); w0.y = cvt_pk_bf16(v00[2], v00[3]); w0.z = cvt_pk_bf16(v01[0], v01[1]); w0.w = cvt_pk_bf16(v01[2], v01[3]);
            w1.x = cvt_pk_bf16(v10[0], v10[1]); w1.y = cvt_pk_bf16(v10[2], v10[3]); w1.z = cvt_pk_bf16(v11[0], v11[1]); w1.w = cvt_pk_bf16(v11[2], v11[3]);
            *(u32x4*)(rowp) = w0; *(u32x4*)(rowp + 32) = w1;
        }
#undef QKV_LDT
    }
};

struct EpiOut {
    static constexpr bool PERM = true, AFTER_DRAIN = false;
    const float* xp; const float* xs; bf16_t* xb; float* rowss;
    __device__ __forceinline__ void operator()(const f32x4 (&acc)[2][2][4][2], const Unit& u, int wr, int wc, int fr, int fq) const {
        const int row0 = u.pm * BM;
        const float* xin = row0 < ROWS_P ? xp + (size_t)row0 * 1024 : xs + (size_t)(row0 - ROWS_P) * 1024;
        const int colb = u.pn * BM + wc * 32 + fq * 8;
        f32x4 xa[2][2], xc[2][2];
#define OUT_LD(k) do { _Pragma("unroll") for (int mm_ = 0; mm_ < 2; ++mm_) { const int rl_ = ((k) >> 1) * HALF + wr * 64 + (2 * ((k) & 1) + mm_) * 16 + fr; \
            _Pragma("unroll") for (int bj_ = 0; bj_ < 2; ++bj_) { const int col_ = colb + bj_ * HALF; \
                xa[mm_][bj_] = *(const f32x4*)(xin + (size_t)rl_ * 1024 + col_); xc[mm_][bj_] = *(const f32x4*)(xin + (size_t)rl_ * 1024 + col_ + 4); } } } while (0)
        OUT_LD(0);
#pragma unroll
        for (int k = 0; k < 4; ++k) {
            const int ai = k >> 1, mh = k & 1;
            u32x4 w[2][2]; float ssv[2];
#pragma unroll
            for (int mm = 0; mm < 2; ++mm) {
                const int m = 2 * mh + mm;
                float ss = 0.f;
#pragma unroll
                for (int bj = 0; bj < 2; ++bj) {
                    const f32x4 a = xa[mm][bj] + acc[ai][bj][m][0];
                    const f32x4 b = xc[mm][bj] + acc[ai][bj][m][1];
                    ss += dot4(a) + dot4(b);
                    w[mm][bj].x = cvt_pk_bf16(a[0], a[1]); w[mm][bj].y = cvt_pk_bf16(a[2], a[3]); w[mm][bj].z = cvt_pk_bf16(b[0], b[1]); w[mm][bj].w = cvt_pk_bf16(b[2], b[3]);
                }
                ss = rows4_sum(ss);
                ssv[mm] = ss;
            }
            if (k + 1 < 4) { OUT_LD(k + 1); }
            asm volatile("" ::: "memory");
#pragma unroll
            for (int mm = 0; mm < 2; ++mm) {
                const int m = 2 * mh + mm;
                const int rl = ai * HALF + wr * 64 + m * 16 + fr; const size_t row = (size_t)row0 + rl;
#pragma unroll
                for (int bj = 0; bj < 2; ++bj) *(u32x4*)(xb + row * 1024 + colb + bj * HALF) = w[mm][bj];
                if (fq == 0) atomicAdd(rowss + row, ssv[mm]);
            }
        }
#undef OUT_LD
    }
};

struct EpiGU {
    static constexpr bool PERM = true, AFTER_DRAIN = false;
    bf16_t* H; const float* rowss;
    __device__ __forceinline__ void operator()(const f32x4 (&acc)[2][2][4][2], const Unit& u, int wr, int wc, int fr, int fq) const {
        const int colh = u.pn * HALF + wc * 32 + fq * 8;
        float rsv[2][4];
#pragma unroll
        for (int ai = 0; ai < 2; ++ai)
#pragma unroll
            for (int m = 0; m < 4; ++m) rsv[ai][m] = rowss[(size_t)u.pm * BM + ai * HALF + wr * 64 + m * 16 + fr];
#pragma unroll
        for (int ai = 0; ai < 2; ++ai)
#pragma unroll
            for (int m = 0; m < 4; ++m) rsv[ai][m] = __builtin_amdgcn_rsqf(rsv[ai][m] * (1.0f / 1024.0f) + NORM_EPS);
#pragma unroll
        for (int ai = 0; ai < 2; ++ai)
#pragma unroll
            for (int m = 0; m < 4; ++m) {
                const size_t row = (size_t)u.pm * BM + ai * HALF + wr * 64 + m * 16 + fr;
                const float rstd = rsv[ai][m]; const float k1 = -rstd * 1.4426950408889634f, k2 = rstd * rstd;
                float hv[8];
#pragma unroll
                for (int n = 0; n < 2; ++n)
#pragma unroll
                    for (int i = 0; i < 4; ++i) {
                        const float ga = acc[ai][0][m][n][i], ua = acc[ai][1][m][n][i];
                        const float e = __builtin_amdgcn_exp2f(ga * k1);
                        hv[n * 4 + i] = (ga * ua) * (k2 * __builtin_amdgcn_rcpf(1.0f + e));
                    }
                u32x4 w; w.x = cvt_pk_bf16(hv[0], hv[1]); w.y = cvt_pk_bf16(hv[2], hv[3]); w.z = cvt_pk_bf16(hv[4], hv[5]); w.w = cvt_pk_bf16(hv[6], hv[7]);
                *(u32x4*)(H + row * 2816 + colh) = w;
            }
    }
};

struct EpiDown {
    static constexpr bool PERM = true, AFTER_DRAIN = false;
    float* out; const bf16_t* xb;
    __device__ __forceinline__ void operator()(const f32x4 (&acc)[2][2][4][2], const Unit& u, int wr, int wc, int fr, int fq) const {
        const int colb = u.pn * BM + wc * 32 + fq * 8;
        u32x4 xw[2][2];
#define DN_LD(k) do { _Pragma("unroll") for (int mm_ = 0; mm_ < 2; ++mm_) { const size_t row_ = (size_t)u.pm * BM + ((k) >> 1) * HALF + wr * 64 + (2 * ((k) & 1) + mm_) * 16 + fr; \
            _Pragma("unroll") for (int bj_ = 0; bj_ < 2; ++bj_) xw[mm_][bj_] = *(const u32x4*)(xb + row_ * 1024 + colb + bj_ * HALF); } } while (0)
        DN_LD(0);
#pragma unroll
        for (int k = 0; k < 4; ++k) {
            const int ai = k >> 1, mh = k & 1;
            f32x4 ra[2][2], rb[2][2];
#pragma unroll
            for (int mm = 0; mm < 2; ++mm) {
                const int m = 2 * mh + mm;
#pragma unroll
                for (int bj = 0; bj < 2; ++bj) {
                    const u32x4 w = xw[mm][bj];
                    f32x4 xa, xc;
                    xa[0] = __builtin_bit_cast(float, w.x << 16); xa[1] = __builtin_bit_cast(float, w.x & 0xffff0000u); xa[2] = __builtin_bit_cast(float, w.y << 16); xa[3] = __builtin_bit_cast(float, w.y & 0xffff0000u);
                    xc[0] = __builtin_bit_cast(float, w.z << 16); xc[1] = __builtin_bit_cast(float, w.z & 0xffff0000u); xc[2] = __builtin_bit_cast(float, w.w << 16); xc[3] = __builtin_bit_cast(float, w.w & 0xffff0000u);
                    ra[mm][bj] = xa + acc[ai][bj][m][0]; rb[mm][bj] = xc + acc[ai][bj][m][1];
                }
            }
            if (k + 1 < 4) { DN_LD(k + 1); }
            asm volatile("" ::: "memory");
#pragma unroll
            for (int mm = 0; mm < 2; ++mm) {
                const size_t row = (size_t)u.pm * BM + ai * HALF + wr * 64 + (2 * mh + mm) * 16 + fr;
#pragma unroll
                for (int bj = 0; bj < 2; ++bj) { float* p = out + row * 1024 + colb + bj * HALF; *(f32x4*)p = ra[mm][bj]; *(f32x4*)(p + 4) = rb[mm][bj]; }
            }
        }
#undef DN_LD
    }
};
}

#ifndef PG8_SP2
#define PG8_SP2 true
#endif
#ifndef PG8_ALIGN
#define PG8_ALIGN true
#endif

constexpr int NWAVES = 8;
constexpr int D = 1024, M = 98304, NIN = 2304, DFF = 2816, NGU = 2 * DFF;
constexpr int ROWS_P = pg8::ROWS_P, SEQ_P = pg8::SEQ_P, SEQ_S = pg8::SEQ_S;
constexpr size_t MiB = 1u << 20;
constexpr size_t WS_ROWSS = 0;
constexpr size_t WS_BAR = 512 * 1024, WS_BAR_BYTES = 16384;
constexpr size_t WS_COS = 1 * MiB, WS_SIN = 3 * MiB;
constexpr size_t WS_WIN = 8 * MiB;
constexpr size_t WS_WOUT = 13 * MiB;
constexpr size_t WS_WGU = 15 * MiB;
constexpr size_t WS_WDN = 26 * MiB;
constexpr size_t WS_XN = 32 * MiB;
constexpr size_t WS_QKV = 232 * MiB;
constexpr size_t WS_H = WS_QKV;
constexpr size_t WS_XB = 768 * MiB;
constexpr size_t WS_END = 960 * MiB;
static_assert(WS_XN + (size_t)M * D * 2 <= WS_QKV && WS_H + (size_t)M * DFF * 2 <= WS_XB && WS_XB + (size_t)M * D * 2 <= WS_END, "d_ws map");

constexpr int RING_BYTES = 131072, LDS_BYTES = 147456;

#define GAS __attribute__((address_space(1)))
#define LAS __attribute__((address_space(3)))
typedef unsigned short bf16;
typedef unsigned v4u __attribute__((ext_vector_type(4)));
typedef float f32x4 __attribute__((ext_vector_type(4)));
__device__ __forceinline__ unsigned f2bf(float f) { unsigned u = __builtin_bit_cast(unsigned, f); return (u + 0x7fffu + ((u >> 16) & 1u)) >> 16; }
__device__ __forceinline__ unsigned pk2(float lo, float hi) { return pg8::cvt_pk_bf16(lo, hi); }
__device__ __forceinline__ float wave_sum(float v) {
#pragma unroll
    for (int o = 1; o < 64; o <<= 1) v += __shfl_xor(v, o);
    return v;
}

__device__ __forceinline__ void p0_transpose_item(const float* W, int K, int N, bf16* WT, int dst_row0, const float* gain, LAS float* scr, int kb, int nb, int lane) {
    const int k0 = 64 * kb, n0 = 32 * nb;
#pragma unroll 8
    for (int i = 0; i < 32; ++i) { const int kk = 2 * i + (lane >> 5); float v = W[(size_t)(k0 + kk) * N + n0 + (lane & 31)]; if (gain) v *= gain[k0 + kk]; scr[kk * 33 + (lane & 31)] = v; }
    asm volatile("s_waitcnt lgkmcnt(0)" ::: "memory");
    const int c = lane & 7;
#pragma unroll
    for (int j = 0; j < 4; ++j) { const int n = (lane >> 3) + 8 * j; const LAS float* s = scr + (8 * c) * 33 + n;
        v4u o; o.x = pk2(s[0 * 33], s[1 * 33]); o.y = pk2(s[2 * 33], s[3 * 33]); o.z = pk2(s[4 * 33], s[5 * 33]); o.w = pk2(s[6 * 33], s[7 * 33]);
        *(v4u*)(WT + (size_t)(dst_row0 + n) * K + k0 + 8 * c) = o; }
    asm volatile("s_waitcnt lgkmcnt(0)" ::: "memory");
}

__device__ const float ROPE_INV[32] = {
    1.000000000e+00f, 7.498942614e-01f, 5.623413324e-01f, 4.216965139e-01f, 3.162277639e-01f, 2.371373773e-01f, 1.778279394e-01f, 1.333521307e-01f,
    1.000000015e-01f, 7.498941571e-02f, 5.623413250e-02f, 4.216965288e-02f, 3.162277490e-02f, 2.371373773e-02f, 1.778279431e-02f, 1.333521493e-02f,
    9.999999776e-03f, 7.498941850e-03f, 5.623413250e-03f, 4.216964822e-03f, 3.162277630e-03f, 2.371373586e-03f, 1.778279431e-03f, 1.333521446e-03f,
    1.000000047e-03f, 7.498942432e-04f, 5.623413017e-04f, 4.216965172e-04f, 3.162277571e-04f, 2.371373703e-04f, 1.778279402e-04f, 1.333521504e-04f};

__device__ __forceinline__ void rope_entry(int pos, int j, float& co, float& si) {
    const float ang = (float)pos * ROPE_INV[j];
    const double a = (double)ang;
    const double k = __builtin_rint(a * 0.15915494309189535);
    double r = __builtin_fma(-k, 6.283185307179586, a); r = __builtin_fma(-k, 2.4492935982947064e-16, r);
    const double q = __builtin_rint(r * 0.6366197723675814);
    double x = __builtin_fma(-q, 1.5707963267948966, r); x = __builtin_fma(-q, 6.123233995736766e-17, x);
    const double x2 = x * x;
    const double s = x * (1.0 + x2 * (-1.0 / 6 + x2 * (1.0 / 120 + x2 * (-1.0 / 5040 + x2 * (1.0 / 362880 + x2 * (-1.0 / 39916800 + x2 * (1.0 / 6227020800.0)))))));
    const double c = 1.0 + x2 * (-0.5 + x2 * (1.0 / 24 + x2 * (-1.0 / 720 + x2 * (1.0 / 40320 + x2 * (-1.0 / 3628800 + x2 * (1.0 / 479001600 + x2 * (-1.0 / 87178291200.0)))))));
    const int qi = ((int)q) & 3;
    const double sn = (qi == 0) ? s : (qi == 1) ? c : (qi == 2) ? -s : -c;
    const double cs = (qi == 0) ? c : (qi == 1) ? -s : (qi == 2) ? -c : s;
    co = (float)cs; si = (float)sn;
}

namespace att {
typedef short bf16x8 __attribute__((ext_vector_type(8)));
typedef short s16x4 __attribute__((ext_vector_type(4)));
typedef float f32x16 __attribute__((ext_vector_type(16)));
typedef unsigned u32x4 __attribute__((ext_vector_type(4)));
typedef unsigned u32x2 __attribute__((ext_vector_type(2)));
typedef float f32x2_t __attribute__((ext_vector_type(2))); typedef __bf16 bf16x2_t __attribute__((ext_vector_type(2)));
typedef short v4i16_t __attribute__((ext_vector_type(4)));
constexpr int QP = 64;
constexpr size_t HS = (size_t)(M + M / 16) * 64;
__device__ __forceinline__ size_t rofs(int r) { return (size_t)(r + (r >> 4)) * 64; }
constexpr int VS = 144;
constexpr int VIMG_BYTES = 32 * VS;
constexpr int LDS_O1 = NWAVES * 2 * VIMG_BYTES, O1S = 136, LDS_L1 = LDS_O1 + 512 * O1S, LDS_ATT_END = LDS_L1 + 512 * 4;
static_assert(LDS_ATT_END <= LDS_BYTES, "attention LDS map");
constexpr int N_UNITS_A = (M / 512) * 8, N_ITEMS_B = M / 32 * 8;
#ifndef ATT_REP_A
#define ATT_REP_A 1
#endif
#ifndef ATT_REP_B
#define ATT_REP_B 1
#endif
__device__ __forceinline__ unsigned cvtpk(float lo, float hi) { f32x2_t v = {lo, hi}; bf16x2_t b = __builtin_convertvector(v, bf16x2_t); return __builtin_bit_cast(unsigned, b); }
__device__ __forceinline__ s16x4 vtr(const LAS char* p) { return __builtin_bit_cast(s16x4, __builtin_amdgcn_ds_read_tr16_b64_v4i16((LAS v4i16_t*)p)); }
__device__ __forceinline__ float bflo(unsigned w) { return __builtin_bit_cast(float, w << 16); }
__device__ __forceinline__ float bfhi(unsigned w) { return __builtin_bit_cast(float, w & 0xffff0000u); }

__device__ __forceinline__ f32x16 qk(const bf16x8 (&kf)[4], const bf16x8 (&qf)[4]) {
    f32x16 sc;
#pragma unroll
    for (int r = 0; r < 16; ++r) sc[r] = 0.f;
#pragma unroll
    for (int s = 0; s < 4; ++s) sc = __builtin_amdgcn_mfma_f32_32x32x16_bf16(kf[s], qf[s], sc, 0, 0, 0);
    return sc;
}

__device__ __forceinline__ void tile_finish(f32x16& o0, f32x16& o1, float& lsum, f32x16 sc, const bf16x8 (&vf)[4], bool safe, int tb, int lb, int L) {
    if (!safe) {
#pragma unroll
        for (int r = 0; r < 16; ++r) {
            const int cr = (r & 3) + 8 * (r >> 2);
            const bool ok = ((unsigned)(tb + cr) <= 128u) && ((unsigned)(lb + cr) < (unsigned)L);
            sc[r] = ok ? sc[r] : -INFINITY;
        }
    }
    float p[16];
#pragma unroll
    for (int r = 0; r < 16; ++r) { p[r] = __builtin_amdgcn_exp2f(sc[r]); lsum += p[r]; }
    u32x4 pw0, pw1;
    pw0.x = cvtpk(p[0], p[1]); pw0.y = cvtpk(p[2], p[3]); pw0.z = cvtpk(p[4], p[5]); pw0.w = cvtpk(p[6], p[7]);
    pw1.x = cvtpk(p[8], p[9]); pw1.y = cvtpk(p[10], p[11]); pw1.z = cvtpk(p[12], p[13]); pw1.w = cvtpk(p[14], p[15]);
    const bf16x8 pf0 = __builtin_bit_cast(bf16x8, pw0), pf1 = __builtin_bit_cast(bf16x8, pw1);
    o0 = __builtin_amdgcn_mfma_f32_32x32x16_bf16(vf[0], pf0, o0, 0, 0, 0);
    o1 = __builtin_amdgcn_mfma_f32_32x32x16_bf16(vf[1], pf0, o1, 0, 0, 0);
    o0 = __builtin_amdgcn_mfma_f32_32x32x16_bf16(vf[2], pf1, o0, 0, 0, 0);
    o1 = __builtin_amdgcn_mfma_f32_32x32x16_bf16(vf[3], pf1, o1, 0, 0, 0);
}
__device__ __forceinline__ void tile_block(f32x16& o0, f32x16& o1, float& lsum, const bf16x8 (&qf)[4], const bf16x8 (&kf)[4], const bf16x8 (&vf)[4], bool safe, int tb, int lb, int L) {
    tile_finish(o0, o1, lsum, qk(kf, qf), vf, safe, tb, lb, L);
}
__device__ __forceinline__ void load_kv2(u32x4 (&kn)[4], u32x4 (&vn)[4], const bf16* kbase, const bf16* vbase, int l0, int L, int rho, int shift, int lane) {
#pragma unroll
    for (int c = 0; c < 4; ++c) { int lv = l0 + 8 * c + (lane >> 3); lv = lv < 0 ? 0 : (lv > L - 1 ? L - 1 : lv);
        const size_t ro = rofs(rho + (lv << shift));
        kn[c] = *(const u32x4*)(kbase + ro); vn[c] = *(const u32x4*)(vbase + ro); }
}
__device__ __forceinline__ void pre_kv(u32x4 (&kn)[4], u32x4 (&vn)[4], const bf16* kbase, const bf16* vbase, int lstart, int L, int rho, int shift, int lane) {
    const int b_lo = (lstart < -31) ? ((-lstart) >> 5) : 0;
    load_kv2(kn, vn, kbase, vbase, lstart + 32 * b_lo, L, rho, shift, lane);
}
template <bool DUAL>
__device__ __forceinline__ void run_branch2(f32x16& oA0, f32x16& oA1, float& lsA, const bf16x8 (&qfA)[4], f32x16& oB0, f32x16& oB1, float& lsB, const bf16x8 (&qfB)[4],
                                            const bf16* kbase, const bf16* vbase, int rho, int shift, int L, int lstart, u32x4 (&kn)[4], u32x4 (&vn)[4], LAS char* vimg, int lane) {
    const int qi = lane & 31, hi = lane >> 5;
    const int tqA = qi - 4 * hi, tqB = tqA + 32;
    const int b_lo = (lstart < -31) ? ((-lstart) >> 5) : 0;
    int b_hi = (L - lstart + 31) >> 5; if (b_hi > (DUAL ? 6 : 5)) b_hi = DUAL ? 6 : 5;
    const LAS char* krd = vimg + qi * VS + hi * 16;
    const LAS char* vrd = vimg + VIMG_BYTES + (4 * hi + ((lane & 15) >> 2)) * VS + ((lane >> 4) & 1) * 32 + (lane & 3) * 8;
    LAS char* kwr = vimg + (lane >> 3) * VS + (lane & 7) * 16;
#pragma unroll 1
    for (int b = b_lo; b < b_hi; ++b) {
#pragma unroll
        for (int c = 0; c < 4; ++c) { *(LAS u32x4*)(kwr + c * 8 * VS) = kn[c]; *(LAS u32x4*)(kwr + VIMG_BYTES + c * 8 * VS) = vn[c]; }
        if (b + 1 < b_hi) load_kv2(kn, vn, kbase, vbase, lstart + 32 * (b + 1), L, rho, shift, lane);
        bf16x8 kf[4], vf[4];
#pragma unroll
        for (int s = 0; s < 4; ++s) kf[s] = *(const LAS bf16x8*)(krd + 32 * s);
#define ATT_VF(t, d0) __builtin_shufflevector(vtr(vrd + (16 * (t)) * VS + 64 * (d0)), vtr(vrd + (16 * (t) + 8) * VS + 64 * (d0)), 0, 1, 2, 3, 4, 5, 6, 7)
        vf[0] = ATT_VF(0, 0); vf[1] = ATT_VF(0, 1); vf[2] = ATT_VF(1, 0); vf[3] = ATT_VF(1, 1);
#undef ATT_VF
        const int l0 = lstart + 32 * b;
        const bool inr = (l0 >= 0) && (l0 + 31 < L);
        if (b <= 4) tile_block(oA0, oA1, lsA, qfA, kf, vf, inr && b >= 1 && b <= 3, 32 * b - tqA, l0 + 4 * hi, L);
        if (DUAL && b >= 1) tile_block(oB0, oB1, lsB, qfB, kf, vf, inr && b >= 2 && b <= 4, 32 * b - tqB, l0 + 4 * hi, L);
    }
}

__device__ __forceinline__ void run_branch1(f32x16& o0, f32x16& o1, float& lsum, const bf16x8 (&qf)[4], const bf16* kbase, const bf16* vbase, int rho, int shift, int L, int lstart,
                                            u32x4 (&kn)[4], u32x4 (&vn)[4], LAS char* vimg, int lane) {
    const int qi = lane & 31, hi = lane >> 5;
    const int tq = qi - 4 * hi;
    const int b_lo = (lstart < -31) ? ((-lstart) >> 5) : 0;
    int b_hi = (L - lstart + 31) >> 5; if (b_hi > 5) b_hi = 5;
    const LAS char* krd = vimg + qi * VS + hi * 16;
    const LAS char* vrd = vimg + VIMG_BYTES + (4 * hi + ((lane & 15) >> 2)) * VS + ((lane >> 4) & 1) * 32 + (lane & 3) * 8;
    LAS char* kwr = vimg + (lane >> 3) * VS + (lane & 7) * 16;
#define ATT_VF(t, d0) __builtin_shufflevector(vtr(vrd + (16 * (t)) * VS + 64 * (d0)), vtr(vrd + (16 * (t) + 8) * VS + 64 * (d0)), 0, 1, 2, 3, 4, 5, 6, 7)
#define R1_STAGE_QK(bn, scX, vfX) do { \
        _Pragma("unroll") for (int c = 0; c < 4; ++c) { *(LAS u32x4*)(kwr + c * 8 * VS) = kn[c]; *(LAS u32x4*)(kwr + VIMG_BYTES + c * 8 * VS) = vn[c]; } \
        if ((bn) + 1 < b_hi) load_kv2(kn, vn, kbase, vbase, lstart + 32 * ((bn) + 1), L, rho, shift, lane); \
        bf16x8 kf_[4]; \
        _Pragma("unroll") for (int s = 0; s < 4; ++s) kf_[s] = *(const LAS bf16x8*)(krd + 32 * s); \
        scX = qk(kf_, qf); \
        vfX[0] = ATT_VF(0, 0); vfX[1] = ATT_VF(0, 1); vfX[2] = ATT_VF(1, 0); vfX[3] = ATT_VF(1, 1); } while (0)
#define R1_FIN(bb, scX, vfX) do { const int l0_ = lstart + 32 * (bb); \
        tile_finish(o0, o1, lsum, scX, vfX, (l0_ >= 0) && (l0_ + 31 < L) && (bb) >= 1 && (bb) <= 3, 32 * (bb) - tq, l0_ + 4 * hi, L); } while (0)
    f32x16 scA, scB; bf16x8 vfA[4], vfB[4];
    int b = b_lo;
    R1_STAGE_QK(b, scA, vfA);
#pragma unroll 1
    for (; b + 1 < b_hi; b += 2) {
        R1_STAGE_QK(b + 1, scB, vfB);
        R1_FIN(b, scA, vfA);
        if (b + 2 < b_hi) R1_STAGE_QK(b + 2, scA, vfA);
        R1_FIN(b + 1, scB, vfB);
    }
    if (b < b_hi) R1_FIN(b, scA, vfA);
#undef R1_STAGE_QK
#undef R1_FIN
#undef ATT_VF
}

__device__ __forceinline__ void store_out(const f32x16& o0, const f32x16& o1, float inv, bf16* out0, size_t rstride, LAS char* stg, int lane) {
    const int qi = lane & 31, hi = lane >> 5;
    LAS char* w = stg + qi * VS + 8 * hi;
#pragma unroll
    for (int c = 0; c < 4; ++c) {
        u32x2 w0, w1;
        w0.x = cvtpk(o0[4 * c] * inv, o0[4 * c + 1] * inv); w0.y = cvtpk(o0[4 * c + 2] * inv, o0[4 * c + 3] * inv);
        w1.x = cvtpk(o1[4 * c] * inv, o1[4 * c + 1] * inv); w1.y = cvtpk(o1[4 * c + 2] * inv, o1[4 * c + 3] * inv);
        *(LAS u32x2*)(w + 16 * c) = w0; *(LAS u32x2*)(w + 64 + 16 * c) = w1;
    }
#pragma unroll
    for (int j = 0; j < 4; ++j) {
        const int row = 8 * j + (lane >> 3), ch = lane & 7;
        const u32x4 v = *(const LAS u32x4*)(stg + row * VS + ch * 16);
        *(u32x4*)(out0 + (size_t)row * rstride + ch * 8) = v;
    }
}

__device__ __forceinline__ void attention_phase(const bf16* QKV, bf16* AO, const float* sink, LAS unsigned char* lds, int vcu, int G, int wave, int lane) {
    const int qi = lane & 31, hi = lane >> 5;
    LAS char* vimg = (LAS char*)lds + wave * (2 * VIMG_BYTES);
    LAS char* O1 = (LAS char*)lds + LDS_O1; LAS float* L1 = (LAS float*)((LAS char*)lds + LDS_L1);
    {
    u32x4 kn[4], vn[4]; bf16x8 qA[4], qB[4];
#define QLD(dst, hh, row) do { const bf16* qp_ = QKV + (size_t)(hh) * HS + rofs((int)(row)) + 8 * hi; _Pragma("unroll") for (int s_ = 0; s_ < 4; ++s_) dst[s_] = *(const bf16x8*)(qp_ + 16 * s_); } while (0)
#define UNIT_PARAMS(uu, h, S, seq_row, pc, kb_, vb_) const int h = (uu) / (M / 512); const int rowc_##h = ((uu) % (M / 512)) * 512; const int S = rowc_##h < ROWS_P ? SEQ_P : SEQ_S; \
        const int seq_row = rowc_##h & ~(S - 1), pc = rowc_##h - seq_row; const bf16* kb_ = QKV + rofs(seq_row) + (8 + h) * HS + (lane & 7) * 8; const bf16* vb_ = QKV + rofs(seq_row) + (16 + h) * HS + (lane & 7) * 8
    if (vcu < N_UNITS_A) { UNIT_PARAMS(vcu, h0, S0, sr0, pc0, kb0, vb0); const int P0 = pc0 + 64 * wave;
        QLD(qA, h0, sr0 + P0 + qi); QLD(qB, h0, sr0 + P0 + 32 + qi); pre_kv(kn, vn, kb0, vb0, P0 - 64, S0, 0, 0, lane); }
    for (int u = vcu; u < N_UNITS_A; u += G) {
        UNIT_PARAMS(u, h, S, seq_row, pc, kb_, vb_);
        {
            const int P0 = pc + 64 * wave;
            f32x16 oA0, oA1, oB0, oB1; float lsA = 0.f, lsB = 0.f;
#pragma unroll
            for (int r = 0; r < 16; ++r) { oA0[r] = 0.f; oA1[r] = 0.f; oB0[r] = 0.f; oB1[r] = 0.f; }
            run_branch2<true>(oA0, oA1, lsA, qA, oB0, oB1, lsB, qB, kb_, vb_, 0, 0, S, P0 - 64, kn, vn, vimg, lane);
            { const int P0b = pc + (wave & 3) + 256 * (wave >> 2);
              QLD(qA, h, seq_row + P0b + 4 * qi); QLD(qB, h, seq_row + P0b + 128 + 4 * qi); pre_kv(kn, vn, kb_, vb_, (P0b >> 2) - 64, S >> 2, P0b & 3, 2, lane); }
            lsA += __shfl_xor(lsA, 32); lsB += __shfl_xor(lsB, 32);
            LAS char* orowA = O1 + (64 * wave + qi) * O1S + 8 * hi; LAS char* orowB = orowA + 32 * O1S;
#pragma unroll
            for (int c = 0; c < 4; ++c) {
                u32x2 w0, w1;
                w0.x = cvtpk(oA0[4 * c], oA0[4 * c + 1]); w0.y = cvtpk(oA0[4 * c + 2], oA0[4 * c + 3]);
                w1.x = cvtpk(oA1[4 * c], oA1[4 * c + 1]); w1.y = cvtpk(oA1[4 * c + 2], oA1[4 * c + 3]);
                *(LAS u32x2*)(orowA + 16 * c) = w0; *(LAS u32x2*)(orowA + 64 + 16 * c) = w1;
                w0.x = cvtpk(oB0[4 * c], oB0[4 * c + 1]); w0.y = cvtpk(oB0[4 * c + 2], oB0[4 * c + 3]);
                w1.x = cvtpk(oB1[4 * c], oB1[4 * c + 1]); w1.y = cvtpk(oB1[4 * c + 2], oB1[4 * c + 3]);
                *(LAS u32x2*)(orowB + 16 * c) = w0; *(LAS u32x2*)(orowB + 64 + 16 * c) = w1;
            }
            if (hi == 0) { L1[64 * wave + qi] = lsA; L1[64 * wave + 32 + qi] = lsB; }
        }
        __syncthreads();
        {
            const int c = wave & 3, tp = wave >> 2, P0 = pc + c + 256 * tp;
            f32x16 oA0, oA1, oB0, oB1; float lsA = 0.f, lsB = 0.f;
#pragma unroll
            for (int r = 0; r < 16; ++r) { oA0[r] = 0.f; oA1[r] = 0.f; oB0[r] = 0.f; oB1[r] = 0.f; }
            run_branch2<true>(oA0, oA1, lsA, qA, oB0, oB1, lsB, qB, kb_, vb_, P0 & 3, 2, S >> 2, (P0 >> 2) - 64, kn, vn, vimg, lane);
            { const int P0c = pc + wave;
              QLD(qA, h, seq_row + P0c + 16 * qi); pre_kv(kn, vn, kb_, vb_, (P0c >> 4) - 64, S >> 4, P0c & 15, 4, lane); }
            lsA += __shfl_xor(lsA, 32); lsB += __shfl_xor(lsB, 32);
            const int lrowA = P0 - pc + 4 * qi, lrowB = lrowA + 128;
            lsA += L1[lrowA]; lsB += L1[lrowB];
            LAS char* prowA = O1 + lrowA * O1S + 8 * hi; LAS char* prowB = prowA + 128 * O1S;
#pragma unroll
            for (int cc = 0; cc < 4; ++cc) {
                u32x2 r0 = *(const LAS u32x2*)(prowA + 16 * cc), r1 = *(const LAS u32x2*)(prowA + 64 + 16 * cc);
                u32x2 w0, w1;
                w0.x = cvtpk(oA0[4 * cc] + bflo(r0.x), oA0[4 * cc + 1] + bfhi(r0.x)); w0.y = cvtpk(oA0[4 * cc + 2] + bflo(r0.y), oA0[4 * cc + 3] + bfhi(r0.y));
                w1.x = cvtpk(oA1[4 * cc] + bflo(r1.x), oA1[4 * cc + 1] + bfhi(r1.x)); w1.y = cvtpk(oA1[4 * cc + 2] + bflo(r1.y), oA1[4 * cc + 3] + bfhi(r1.y));
                *(LAS u32x2*)(prowA + 16 * cc) = w0; *(LAS u32x2*)(prowA + 64 + 16 * cc) = w1;
                r0 = *(const LAS u32x2*)(prowB + 16 * cc); r1 = *(const LAS u32x2*)(prowB + 64 + 16 * cc);
                w0.x = cvtpk(oB0[4 * cc] + bflo(r0.x), oB0[4 * cc + 1] + bfhi(r0.x)); w0.y = cvtpk(oB0[4 * cc + 2] + bflo(r0.y), oB0[4 * cc + 3] + bfhi(r0.y));
                w1.x = cvtpk(oB1[4 * cc] + bflo(r1.x), oB1[4 * cc + 1] + bfhi(r1.x)); w1.y = cvtpk(oB1[4 * cc + 2] + bflo(r1.y), oB1[4 * cc + 3] + bfhi(r1.y));
                *(LAS u32x2*)(prowB + 16 * cc) = w0; *(LAS u32x2*)(prowB + 64 + 16 * cc) = w1;
            }
            if (hi == 0) { L1[lrowA] = lsA; L1[lrowB] = lsB; }
        }
        __syncthreads();
#define FINALIZE_ITEM(r_, P0_) do { lsum += __shfl_xor(lsum, 32); const int lrow = (r_) + 16 * qi; lsum += L1[lrow]; const LAS char* prow = O1 + lrow * O1S + 8 * hi; \
            _Pragma("unroll") for (int c = 0; c < 4; ++c) { const u32x2 w0 = *(const LAS u32x2*)(prow + 16 * c), w1 = *(const LAS u32x2*)(prow + 64 + 16 * c); \
                o0[4 * c] += bflo(w0.x); o0[4 * c + 1] += bfhi(w0.x); o0[4 * c + 2] += bflo(w0.y); o0[4 * c + 3] += bfhi(w0.y); \
                o1[4 * c] += bflo(w1.x); o1[4 * c + 1] += bfhi(w1.x); o1[4 * c + 2] += bflo(w1.y); o1[4 * c + 3] += bfhi(w1.y); } \
            store_out(o0, o1, 1.0f / lsum, AO + (size_t)(seq_row + (P0_)) * 1024 + h * 64, (size_t)16 * 1024, vimg, lane); } while (0)
        {
            const int P0 = pc + wave;
            f32x16 o0, o1; float lsum = 0.f;
#pragma unroll
            for (int rr = 0; rr < 16; ++rr) { o0[rr] = 0.f; o1[rr] = 0.f; }
            run_branch1(o0, o1, lsum, qA, kb_, vb_, P0 & 15, 4, S >> 4, (P0 >> 4) - 64, kn, vn, vimg, lane);
            { const int P0d = pc + wave + 8;
              QLD(qB, h, seq_row + P0d + 16 * qi); pre_kv(kn, vn, kb_, vb_, (P0d >> 4) - 64, S >> 4, P0d & 15, 4, lane); }
            FINALIZE_ITEM(wave, P0);
        }
        {
            const int P0 = pc + wave + 8;
            f32x16 o0, o1; float lsum = 0.f;
#pragma unroll
            for (int rr = 0; rr < 16; ++rr) { o0[rr] = 0.f; o1[rr] = 0.f; }
            run_branch1(o0, o1, lsum, qB, kb_, vb_, P0 & 15, 4, S >> 4, (P0 >> 4) - 64, kn, vn, vimg, lane);
            if (u + G < N_UNITS_A) { UNIT_PARAMS(u + G, hn, Sn, srn, pcn, kbn, vbn); const int P0n = pcn + 64 * wave;
                QLD(qA, hn, srn + P0n + qi); QLD(qB, hn, srn + P0n + 32 + qi); pre_kv(kn, vn, kbn, vbn, P0n - 64, Sn, 0, 0, lane); }
            FINALIZE_ITEM(wave + 8, P0);
        }
#undef FINALIZE_ITEM
        __syncthreads();
    }
#undef QLD
#undef UNIT_PARAMS
    }
    {
        constexpr int KVB = 2 * VIMG_BYTES;
        constexpr int N_UNITS_B = 2 * (M / 64), UPW = 12;
        static_assert(10 * KVB + NWAVES * VIMG_BYTES <= LDS_BYTES, "mixer B LDS map");
        const int tid = wave * 64 + lane, chunk = tid & 7, r0 = tid >> 3;
        LAS char* kvw = (LAS char*)lds + (r0 >> 5) * KVB + (r0 & 31) * VS + chunk * 16;
        const int tile = wave >> 2, hq = wave & 3;
        const LAS char* krd = (const LAS char*)lds + (lane & 31) * VS + hi * 16;
        const LAS char* vrd = (const LAS char*)lds + VIMG_BYTES + (4 * hi + ((lane & 15) >> 2)) * VS + ((lane >> 4) & 1) * 32 + (lane & 3) * 8;
        u32x4 rk[5], rv[5]; bf16x8 qn[4];
        auto unit_ptrs = [&](int u, int& g, int& p0, int& S, int& seq_row) { g = u / (M / 64); const int row0 = (u % (M / 64)) * 64; S = row0 < ROWS_P ? SEQ_P : SEQ_S; seq_row = row0 & ~(S - 1); p0 = row0 - seq_row; };
        const int u_begin = (G == 256) ? vcu * UPW : vcu, u_step = (G == 256) ? 1 : G, u_count = (G == 256) ? UPW : (N_UNITS_B - vcu + G - 1) / G;
#define MB_LOAD(u) do { int g_, p0_, S_, sr_; unit_ptrs((u), g_, p0_, S_, sr_); const bf16* kb2 = QKV + (32 + g_) * HS + rofs(sr_) + chunk * 8; \
        { const bf16* qp_ = QKV + (24 + 4 * g_ + hq) * HS + rofs(sr_ + p0_ + 32 * tile + qi) + 8 * hi; _Pragma("unroll") for (int s = 0; s < 4; ++s) qn[s] = *(const bf16x8*)(qp_ + 16 * s); } \
        _Pragma("unroll") for (int j = 0; j < 5; ++j) { int l = p0_ - 128 + r0 + 64 * j; l = l < 0 ? 0 : (l > S_ - 1 ? S_ - 1 : l); \
            rk[j] = *(const u32x4*)(kb2 + rofs(l)); rv[j] = *(const u32x4*)(kb2 + 2 * HS + rofs(l)); } } while (0)
        for (int rep = 0; rep < ATT_REP_B; ++rep) {
        if (u_count > 0) MB_LOAD(u_begin);
#pragma unroll 1
        for (int ui = 0; ui < u_count; ++ui) {
            const int u = u_begin + ui * u_step;
            int g, p0, S, seq_row; unit_ptrs(u, g, p0, S, seq_row);
#pragma unroll
            for (int j = 0; j < 5; ++j) { *(LAS u32x4*)(kvw + 2 * j * KVB) = rk[j]; *(LAS u32x4*)(kvw + 2 * j * KVB + VIMG_BYTES) = rv[j]; }
            __syncthreads();
            bf16x8 qf[4];
#pragma unroll
            for (int s = 0; s < 4; ++s) qf[s] = qn[s];
            if (ui + 1 < u_count) MB_LOAD(u + u_step);
            const int hb = 4 * g + hq, P0 = p0 + 32 * tile;
            const size_t qrow = (size_t)(seq_row + P0 + qi);
            f32x16 o0, o1; float lsum = (hi == 0) ? __builtin_amdgcn_exp2f(sink[hb] * 1.4426950408889634f) : 0.f;
#pragma unroll
            for (int r = 0; r < 16; ++r) { o0[r] = 0.f; o1[r] = 0.f; }
            const int lstart = P0 - 128;
            const int b_lo = (lstart < -31) ? ((-lstart) >> 5) : 0;
            int b_hi = (S - lstart + 31) >> 5; if (b_hi > 9) b_hi = 9;
            const int tq = qi - 4 * hi;
#define MB_QK(b, scv, vfv) do { \
                const LAS char* kp = krd + ((b) + tile) * KVB; \
                bf16x8 kf[4]; \
                _Pragma("unroll") for (int s = 0; s < 4; ++s) kf[s] = *(const LAS bf16x8*)(kp + 32 * s); \
                scv = qk(kf, qf); \
                const LAS char* vr = vrd + ((b) + tile) * KVB; \
                vfv[0] = ATT_VF(0, 0); vfv[1] = ATT_VF(0, 1); vfv[2] = ATT_VF(1, 0); vfv[3] = ATT_VF(1, 1); } while (0)
#define MB_FIN(b, scv, vfv) do { \
                const int l0 = lstart + 32 * (b); \
                const bool safe_ = ((b) >= 1) && ((b) <= 7) && (l0 >= 0) && (l0 + 31 < S); \
                if (!safe_) { \
                    const int tb = 32 * (b) - tq, lb = l0 + 4 * hi; \
                    _Pragma("unroll") for (int r = 0; r < 16; ++r) { \
                        const int cr = (r & 3) + 8 * (r >> 2); \
                        const bool ok = ((unsigned)(tb + cr) <= 256u) && ((unsigned)(lb + cr) < (unsigned)S); \
                        scv[r] = ok ? scv[r] : -INFINITY; } } \
                float p[16]; \
                _Pragma("unroll") for (int r = 0; r < 16; ++r) { p[r] = __builtin_amdgcn_exp2f(scv[r]); lsum += p[r]; } \
                u32x4 pw0, pw1; \
                pw0.x = cvtpk(p[0], p[1]); pw0.y = cvtpk(p[2], p[3]); pw0.z = cvtpk(p[4], p[5]); pw0.w = cvtpk(p[6], p[7]); \
                pw1.x = cvtpk(p[8], p[9]); pw1.y = cvtpk(p[10], p[11]); pw1.z = cvtpk(p[12], p[13]); pw1.w = cvtpk(p[14], p[15]); \
                const bf16x8 pf0 = __builtin_bit_cast(bf16x8, pw0), pf1 = __builtin_bit_cast(bf16x8, pw1); \
                o0 = __builtin_amdgcn_mfma_f32_32x32x16_bf16(vfv[0], pf0, o0, 0, 0, 0); \
                o1 = __builtin_amdgcn_mfma_f32_32x32x16_bf16(vfv[1], pf0, o1, 0, 0, 0); \
                o0 = __builtin_amdgcn_mfma_f32_32x32x16_bf16(vfv[2], pf1, o0, 0, 0, 0); \
                o1 = __builtin_amdgcn_mfma_f32_32x32x16_bf16(vfv[3], pf1, o1, 0, 0, 0); } while (0)
#define ATT_VF(t, d0) __builtin_shufflevector(vtr(vr + (16 * (t)) * VS + 64 * (d0)), vtr(vr + (16 * (t) + 8) * VS + 64 * (d0)), 0, 1, 2, 3, 4, 5, 6, 7)
            {
                f32x16 scA, scB; bf16x8 vfA[4], vfB[4];
                int b = b_lo;
                MB_QK(b, scA, vfA);
#pragma unroll 1
                for (; b + 1 < b_hi; b += 2) {
                    MB_QK(b + 1, scB, vfB);
                    MB_FIN(b, scA, vfA);
                    if (b + 2 < b_hi) MB_QK(b + 2, scA, vfA);
                    MB_FIN(b + 1, scB, vfB);
                }
                if (b < b_hi) MB_FIN(b, scA, vfA);
            }
#undef ATT_VF
#undef MB_QK
#undef MB_FIN
            lsum += __shfl_xor(lsum, 32);
            store_out(o0, o1, 1.0f / lsum, AO + (size_t)(seq_row + P0) * 1024 + 512 + hb * 64, (size_t)1024, (LAS char*)lds + 10 * KVB + wave * VIMG_BYTES, lane);
            __syncthreads();
        }
        }
#undef MB_LOAD
    }
}
}

#define XB_TMO      128
#define XB_XCNT(j)  (256  + 64 * (j))
#define XB_XSUB(j)  (1280 + 64 * (j))
#define XB_XGEN(j)  (2304 + 64 * (j))
#define XB_TOP      3328
#define XB_TOPGEN   3392
#define XCD_BAR_WORDS 3456
#define XB_SPIN_CAP (1u << 18)

__device__ __forceinline__ unsigned xb_ld(unsigned* p)              { return __hip_atomic_load(p, __ATOMIC_RELAXED, __HIP_MEMORY_SCOPE_AGENT); }
__device__ __forceinline__ unsigned xb_add(unsigned* p, unsigned v) { return __hip_atomic_fetch_add(p, v, __ATOMIC_RELAXED, __HIP_MEMORY_SCOPE_AGENT); }
__device__ __forceinline__ unsigned xb_xcc_id() { return (unsigned)__builtin_amdgcn_s_getreg((3 << 11) | 20) & 0xFu; }
#define XB_SPIN(cond, bar) do { unsigned _sp = 0; while (cond) { __builtin_amdgcn_s_sleep(1); \
    if ((++_sp & 255u) == 0u) { if (xb_ld(&(bar)[XB_TMO])) break; if (_sp > XB_SPIN_CAP) { atomicAdd(&(bar)[XB_TMO], 1u); break; } } } } while (0)

struct XcdBarrier {
    unsigned* bar; unsigned x;
    volatile LAS unsigned* st;
};

__device__ __forceinline__ XcdBarrier xcd_barrier_post(unsigned* bar, volatile LAS unsigned* st) {
    XcdBarrier b; b.bar = bar; b.x = xb_xcc_id(); b.st = st;
    if (threadIdx.x == 0) (void)xb_add(&bar[XB_XCNT(b.x)], 1u);
    return b;
}
__device__ __forceinline__ void xcd_barrier_complete(unsigned* bar, unsigned x, unsigned& nloc, unsigned& nx) {
    const unsigned G = gridDim.x * gridDim.y * gridDim.z;
    unsigned sum, cnt, mine, sp = 0u;
    for (;;) {
        sum = 0u; cnt = 0u; mine = 0u;
#pragma unroll
        for (unsigned j = 0; j < 16; ++j) { const unsigned c = xb_ld(&bar[XB_XCNT(j)]); sum += c; cnt += (c > 0u) ? 1u : 0u; mine = (j == x) ? c : mine; }
        if (sum == G) break;
        __builtin_amdgcn_s_sleep(1);
        if ((++sp & 255u) == 0u) { if (xb_ld(&bar[XB_TMO])) break; if (sp > XB_SPIN_CAP) { atomicAdd(&bar[XB_TMO], 1u); break; } }
    }
    nloc = mine > 0u ? mine : 1u; nx = cnt > 0u ? cnt : 1u;
}

__device__ __forceinline__ void xcd_barrier(const XcdBarrier& b) {
    asm volatile("s_waitcnt vmcnt(0)" ::: "memory");
    __syncthreads();
    if (threadIdx.x == 0) {
        unsigned* bar = b.bar;
        __builtin_amdgcn_s_waitcnt(0);
        unsigned nloc = b.st[0], nx = b.st[1];
        if (nloc == 0u) { xcd_barrier_complete(bar, b.x, nloc, nx); b.st[0] = nloc; b.st[1] = nx; }
        const unsigned old = xb_add(&bar[XB_XSUB(b.x)], 1u);
        const unsigned gen = old / nloc;
        if (old + 1u == (gen + 1u) * nloc) {
            __builtin_amdgcn_fence(__ATOMIC_RELEASE, "agent");
            asm volatile("s_waitcnt vmcnt(0)" ::: "memory");
            const unsigned og = xb_add(&bar[XB_TOP], 1u);
            const unsigned tg = og / nx;
            if (og + 1u == (tg + 1u) * nx) xb_add(&bar[XB_TOPGEN], 1u);
            else XB_SPIN(xb_ld(&bar[XB_TOPGEN]) == tg, bar);
            __builtin_amdgcn_fence(__ATOMIC_ACQUIRE, "agent");
            xb_add(&bar[XB_XGEN(b.x)], 1u);
            asm volatile("s_waitcnt vmcnt(0)" ::: "memory");
        } else {
            XB_SPIN(xb_ld(&bar[XB_XGEN(b.x)]) == gen, bar);
            __builtin_amdgcn_fence(__ATOMIC_ACQUIRE, "agent");
            asm volatile("s_waitcnt vmcnt(0)" ::: "memory");
        }
    }
    __syncthreads();
}

struct Args { const float* in[14]; float* out; unsigned char* ws; int ph_lo, ph_hi; };
__global__ void __launch_bounds__(NWAVES * 64, 2) hymba_fwd(Args args) {
    extern __shared__ __attribute__((aligned(16))) unsigned char lds_raw[];
    cg::grid_group grid = cg::this_grid();
    LAS unsigned char* lds = (LAS unsigned char*)lds_raw;
    const int tid = threadIdx.x, lane = tid & 63, wave = __builtin_amdgcn_readfirstlane(tid >> 6);
    const int G = gridDim.x, bx = blockIdx.x;
    const int vcu = (G % 8 == 0) ? (bx % 8) * (G / 8) + bx / 8 : bx;
    const int gw = vcu * NWAVES + wave, NGW = G * NWAVES;
    unsigned char* ws = args.ws;
    const float* xp = args.in[0]; const float* xs = args.in[1]; const float* attn_norm = args.in[2]; const float* w_in = args.in[3];
    const float* qnorm_a = args.in[4]; const float* knorm_a = args.in[5]; const float* qnorm_b = args.in[6]; const float* knorm_b = args.in[7];
    const float* sink_b = args.in[8]; const float* w_out = args.in[9]; const float* ffn_norm = args.in[10]; const float* w_gate = args.in[11];
    const float* w_up = args.in[12]; const float* w_down = args.in[13];
    float* rowss = (float*)(ws + WS_ROWSS); float* cosT = (float*)(ws + WS_COS); float* sinT = (float*)(ws + WS_SIN);
    bf16* Win_t = (bf16*)(ws + WS_WIN); bf16* Wout_t = (bf16*)(ws + WS_WOUT); bf16* Wgu_t = (bf16*)(ws + WS_WGU); bf16* Wdn_t = (bf16*)(ws + WS_WDN);
    bf16* XN = (bf16*)(ws + WS_XN); bf16* AO = XN; bf16* QKV = (bf16*)(ws + WS_QKV); bf16* HB = (bf16*)(ws + WS_H); bf16* XB = (bf16*)(ws + WS_XB);
    const int lo = args.ph_lo, hi = args.ph_hi;
    volatile LAS unsigned* bst = (volatile LAS unsigned*)(lds + LDS_BYTES - 64);
    if (tid < 16) ((LAS unsigned*)(lds + LDS_BYTES - 64))[tid] = 0u;
    __syncthreads();
    XcdBarrier xbar = xcd_barrier_post((unsigned*)(ws + WS_BAR), bst);
    if (lo < 0) grid.sync();
#define IN(k) (lo <= (k) && (k) < hi)
#define SEAM(k) do { if (IN(k) && IN((k) + 1)) xcd_barrier(xbar); } while (0)

    if (IN(0)) {
        LAS float* scr = (LAS float*)(lds + wave * 16384);
        constexpr int I_IN = 16 * 72, I_OUT = 16 * 32, I_G = 16 * 88, I_D = 44 * 32, NITEMS = I_IN + I_OUT + 2 * I_G + I_D;
        for (int it = gw; it < NITEMS; it += NGW) {
            int r = it;
            if (r < I_IN) { const int kb = r / 72, nb = r % 72, n0 = nb * 32; const int dst = 256 * (n0 >> 8) + 128 * ((n0 & 63) >> 5) + 32 * ((n0 & 255) >> 6);
                p0_transpose_item(w_in, D, NIN, Win_t, dst, nullptr, scr, kb, nb, lane); continue; } r -= I_IN;
            if (r < I_OUT) { const int kb = r / 32, nb = r % 32; p0_transpose_item(w_out, D, D, Wout_t, nb * 32, nullptr, scr, kb, nb, lane); continue; } r -= I_OUT;
            if (r < I_G) { const int kb = r / 88, nb = r % 88, n0 = nb * 32; p0_transpose_item(w_gate, D, DFF, Wgu_t, 256 * (n0 >> 7) + (n0 & 127), ffn_norm, scr, kb, nb, lane); continue; } r -= I_G;
            if (r < I_G) { const int kb = r / 88, nb = r % 88, n0 = nb * 32; p0_transpose_item(w_up, D, DFF, Wgu_t, 256 * (n0 >> 7) + 128 + (n0 & 127), ffn_norm, scr, kb, nb, lane); continue; } r -= I_G;
            { const int kb = r / 32, nb = r % 32; p0_transpose_item(w_down, DFF, D, Wdn_t, nb * 32, nullptr, scr, kb, nb, lane); }
        }
        const int gt = gw * 64 + lane, NGT = NGW * 64;
        for (int i = gt; i < SEQ_P * 32; i += NGT) { float c, s; rope_entry(i >> 5, i & 31, c, s); cosT[i] = c; sinT[i] = s; }
        for (int i = gt; i < M; i += NGT) rowss[i] = 0.f;
        for (int m0 = gw; m0 < M; m0 += 4 * NGW) {
            f32x4 v[4][4]; float ssq[4];
#pragma unroll
            for (int q = 0; q < 4; ++q) { const int m = m0 + q * NGW; const int mm = m < M ? m : M - 1;
                const float* xrow = mm < ROWS_P ? xp + (size_t)mm * D : xs + (size_t)(mm - ROWS_P) * D;
                const f32x4* xr = (const f32x4*)xrow + lane;
#pragma unroll
                for (int j = 0; j < 4; ++j) v[q][j] = __builtin_nontemporal_load(xr + 64 * j); }
            const f32x4* gr = (const f32x4*)attn_norm + lane;
#pragma unroll
            for (int q = 0; q < 4; ++q) { float s = 0.f;
#pragma unroll
                for (int j = 0; j < 4; ++j) s += (v[q][j].x * v[q][j].x + v[q][j].y * v[q][j].y) + (v[q][j].z * v[q][j].z + v[q][j].w * v[q][j].w);
                ssq[q] = s; }
#pragma unroll
            for (int q = 0; q < 4; ++q) { const int m = m0 + q * NGW; if (m >= M) continue;
                const float rstd = 1.f / sqrtf(wave_sum(ssq[q]) * (1.f / D) + 1e-6f);
                unsigned long long* o8 = (unsigned long long*)(XN + (size_t)m * D) + lane;
#pragma unroll
                for (int j = 0; j < 4; ++j) { const f32x4 g = gr[64 * j]; o8[64 * j] = (unsigned long long)pk2(v[q][j].x * rstd * g.x, v[q][j].y * rstd * g.y) | ((unsigned long long)pk2(v[q][j].z * rstd * g.z, v[q][j].w * rstd * g.w) << 32); } }
        }
        __syncthreads();
    }
    SEAM(0);
    if (IN(1)) {
        pg8::Gemm g{XN, Win_t, M, NIN, D}; pg8::StaticOrder S; S.init(M, NIN, G, bx);
        pg8::EpiQKV E{QKV, cosT, sinT, qnorm_a, knorm_a, qnorm_b, knorm_b};
        pg8::gemm_phase<pg8::EpiQKV, pg8::StaticOrder, PG8_ALIGN, PG8_SP2>(lds, g, S, E);
    }
    SEAM(1);
    if (IN(2)) att::attention_phase(QKV, AO, sink_b, lds, vcu, G, wave, lane);
    SEAM(2);
    if (IN(3)) {
        pg8::Gemm g{AO, Wout_t, M, D, D}; pg8::StaticOrder S; S.init(M, D, G, bx);
        pg8::EpiOut E{xp, xs, XB, rowss};
        pg8::gemm_phase<pg8::EpiOut, pg8::StaticOrder, PG8_ALIGN, PG8_SP2>(lds, g, S, E);
    }
    SEAM(3);
    if (IN(4)) {
        pg8::Gemm g{XB, Wgu_t, M, NGU, D}; pg8::StaticOrder S; S.init(M, NGU, G, bx);
        pg8::EpiGU E{HB, rowss};
        pg8::gemm_phase<pg8::EpiGU, pg8::StaticOrder, PG8_ALIGN, PG8_SP2>(lds, g, S, E);
    }
    SEAM(4);
    if (IN(5)) {
        pg8::Gemm g{HB, Wdn_t, M, D, DFF}; pg8::StaticOrder S; S.init(M, D, G, bx);
        pg8::EpiDown E{args.out, XB};
        pg8::gemm_phase<pg8::EpiDown, pg8::StaticOrder, PG8_ALIGN, PG8_SP2>(lds, g, S, E);
    }
#undef IN
#undef SEAM
}

#ifndef MK_N_LAUNCHES
#define MK_N_LAUNCHES 1
#endif
extern "C" void kernel_launch(void* const* d_in, const int* in_sizes, int n_in, void* d_out, int out_size, void* d_ws, size_t ws_size, hipStream_t stream) {
    static int grid = 0;
    if (grid == 0) {
        if (n_in != 14 || out_size != M * D || ws_size < WS_END) { fprintf(stderr, "kernel_launch: unexpected shapes (n_in %d, out %d, ws %zu); nothing launched\n", n_in, out_size, ws_size); grid = -1; return; }
        int dev = 0, cus = 0, per_cu = 0;
        if (hipGetDevice(&dev) != hipSuccess || hipDeviceGetAttribute(&cus, hipDeviceAttributeMultiprocessorCount, dev) != hipSuccess) { grid = -1; return; }
        if (hipFuncSetAttribute((const void*)hymba_fwd, hipFuncAttributeMaxDynamicSharedMemorySize, LDS_BYTES) != hipSuccess) { fprintf(stderr, "kernel_launch: hipFuncSetAttribute failed\n"); grid = -1; return; }
        if (hipOccupancyMaxActiveBlocksPerMultiprocessor(&per_cu, (const void*)hymba_fwd, NWAVES * 64, LDS_BYTES) != hipSuccess || per_cu < 1) { fprintf(stderr, "kernel_launch: occupancy query says %d\n", per_cu); per_cu = 1; }
        (void)hipGetLastError();
        grid = cus * 1;
    }
    if (grid < 0) return;
    if (hipMemsetAsync((char*)d_ws + WS_BAR, 0, WS_BAR_BYTES, stream) != hipSuccess) { fprintf(stderr, "kernel_launch: hipMemsetAsync of the barrier words failed; nothing launched\n"); return; }
    Args a{};
    for (int i = 0; i < 14; ++i) a.in[i] = (const float*)d_in[i];
    a.out = (float*)d_out; a.ws = (unsigned char*)d_ws;
    for (int li = 0; li < MK_N_LAUNCHES; ++li) {
        if (MK_N_LAUNCHES == 1) { a.ph_lo = 0; a.ph_hi = 6; } else { a.ph_lo = li; a.ph_hi = li + 1; }
        void* kargs[] = {&a};
        const hipError_t e = hipLaunchCooperativeKernel((const void*)hymba_fwd, dim3(grid), dim3(NWAVES * 64), kargs, LDS_BYTES, stream);
        if (e != hipSuccess) { fprintf(stderr, "kernel_launch: cooperative launch %d failed: %s (grid %d)\n", li, hipGetErrorString(e), grid); break; }
    }
}
```
